# Optimizing an MI355X kernel written in HIP

```python
import jax
import jax.numpy as jnp
from jax import lax
import numpy as np

D_MODEL = 1024
BATCH = 4
SEQ = 4096
DEPTH = 4

GRID_W = 64
CTX_LEN = 256
N_MIXERS = 3
CHUNK = 128
A_DIM = 2 * D_MODEL
A_GROUPS = 8
N_HEADS = 16
N_KV = 4
HEAD_DIM = D_MODEL // N_HEADS
ROPE_FREQS = HEAD_DIM // 4
ROPE_THETA = 10000.0
Q_BLOCK = 128
POOL_WINDOWS = (2, 4, 8, 16)
POOL_GROUP = D_MODEL // 4
FFN_DIM = 2816
N_EXPERTS = 8
TOP_K = 2
EXPERT_DIM = 3584
EPS = 1e-6

N_A = (DEPTH + 2) // 3
N_B = (DEPTH + 1) // 3
N_C = DEPTH // 3
N_DENSE = (DEPTH + 1) // 2
N_MOE = DEPTH // 2

kernel_name = 'hybrid_gmlp_gqa_pool_moe_diffusion_trunk'


def rms_norm(x, g):
    xf = x.astype(jnp.float32)
    y = xf * lax.rsqrt(jnp.mean(xf * xf, axis=-1, keepdims=True) + EPS)
    return (y * g.astype(jnp.float32)).astype(x.dtype)


def adaln(cond, w, b):
    m = jax.nn.silu(cond) @ w + b
    m = m.reshape(m.shape[:-1] + (1, m.shape[-1]))
    if m.ndim == 2:
        m = m[None]
    return jnp.split(m, 6, axis=-1)


def modulate(x, g, shift, scale):
    return rms_norm(x, g) * (1 + scale) + shift


def swiglu(t, wg, wu, wd):
    return (jax.nn.silu(t @ wg) * (t @ wu)) @ wd


def moe_swiglu(h, router, wg, wu, wd):
    b, l, d = h.shape
    t = h.reshape(b * l, d)
    logits = (t @ router).astype(jnp.float32)
    top_v, top_i = lax.top_k(logits, TOP_K)
    gates = jax.nn.softmax(top_v, axis=-1)
    combine = jnp.sum(jax.nn.one_hot(top_i, N_EXPERTS, dtype=jnp.float32) * gates[..., None], axis=1)
    combine = combine.astype(t.dtype)
    out = jnp.zeros_like(t)
    for e in range(N_EXPERTS):
        out = out + combine[:, e:e + 1] * swiglu(t, wg[e], wu[e], wd[e])
    return out.reshape(b, l, d)


def chunk_mlp(h, w_in, v_g, w_s, b_s, w_out):
    b, l, _ = h.shape
    z = jax.nn.gelu(h @ w_in)
    u, v = jnp.split(z, 2, axis=-1)
    v = rms_norm(v, v_g).reshape(b, l // CHUNK, CHUNK, A_GROUPS, A_DIM // A_GROUPS)
    mixed = jnp.einsum('gts,bcsgd->bctgd', w_s, v) + b_s.T[:, :, None]
    return (u * mixed.reshape(b, l, A_DIM)) @ w_out


def centred_pool_minus_identity(x, w):
    b, l, ch = x.shape
    xf = x.astype(jnp.float32)
    cs = jnp.concatenate([jnp.zeros((b, 1, ch), jnp.float32), jnp.cumsum(xf, axis=1)], axis=1)
    t = jnp.arange(l)
    lo = jnp.clip(t - w // 2, 0, l - 1)
    hi = jnp.clip(t + w // 2 - 1, 0, l - 1)
    cnt = (hi - lo + 1).astype(jnp.float32)
    s = jnp.take(cs, hi + 1, axis=1) - jnp.take(cs, lo, axis=1)
    return (s / cnt[None, :, None] - xf).astype(x.dtype)


def pool_mixer(h, p_w, p_scale):
    groups = jnp.split(h, len(POOL_WINDOWS), axis=-1)
    outs = [centred_pool_minus_identity(grp, w) @ p_w[j]
            for j, (grp, w) in enumerate(zip(groups, POOL_WINDOWS))]
    return jnp.concatenate(outs, axis=-1) * p_scale


def axial_rope_tables(rows):
    r = jnp.repeat(jnp.arange(rows), GRID_W)
    col = jnp.tile(jnp.arange(GRID_W), rows)
    inv = ROPE_THETA ** (-jnp.arange(ROPE_FREQS, dtype=jnp.float32) / ROPE_FREQS)
    ang = jnp.stack([r, col], axis=-1).astype(jnp.float32)[..., None] * inv
    return jnp.cos(ang), jnp.sin(ang)


def apply_rope(x, cos, sin):
    shp = x.shape
    xr = x.astype(jnp.float32).reshape(shp[:-1] + (2, 2, ROPE_FREQS))
    x1, x2 = xr[..., 0, :], xr[..., 1, :]
    bshape = (1, shp[1]) + (1,) * (len(shp) - 3) + cos.shape[1:]
    c, s = cos.reshape(bshape), sin.reshape(bshape)
    out = jnp.stack([x1 * c - x2 * s, x2 * c + x1 * s], axis=-2)
    return out.reshape(shp).astype(x.dtype)


def blocked_attention(q, k, v):
    b, lq = q.shape[:2]
    nb = lq // Q_BLOCK
    qb = jnp.moveaxis(q.reshape((b, nb, Q_BLOCK) + q.shape[2:]), 1, 0)
    scale = HEAD_DIM ** -0.5

    def one_block(qi):
        s = jnp.einsum('bqgrd,bkgd->bgrqk', qi, k, preferred_element_type=jnp.float32) * scale
        p = jax.nn.softmax(s, axis=-1).astype(v.dtype)
        return jnp.einsum('bgrqk,bkgd->bqgrd', p, v)

    o = lax.map(one_block, qb)
    return jnp.moveaxis(o, 0, 1).reshape(b, lq, N_HEADS * HEAD_DIM)


def attention_mixer(hl, hc, w_qkv, q_g, k_g, w_o, cos, sin, ctx_out):
    nq = N_HEADS * HEAD_DIM
    rep = N_HEADS // N_KV

    def q_heads(qf):
        return rms_norm(qf.reshape(qf.shape[0], qf.shape[1], N_KV, rep, HEAD_DIM), q_g)

    def kv_heads(kvf):
        kf, vf = jnp.split(kvf, 2, axis=-1)
        kk = rms_norm(kf.reshape(kf.shape[0], kf.shape[1], N_KV, HEAD_DIM), k_g)
        return kk, vf.reshape(vf.shape[0], vf.shape[1], N_KV, HEAD_DIM)

    qkv_l = hl @ w_qkv
    ql = apply_rope(q_heads(qkv_l[..., :nq]), cos, sin)
    kl, vl = kv_heads(qkv_l[..., nq:])
    kl = apply_rope(kl, cos, sin)
    kc, vc = kv_heads(hc @ w_qkv[:, nq:])
    yl = blocked_attention(ql, jnp.concatenate([kc, kl], axis=1), jnp.concatenate([vc, vl], axis=1)) @ w_o
    yc = blocked_attention(q_heads(hc @ w_qkv[:, :nq]), kc, vc) @ w_o if ctx_out else None
    return yl, yc


def setup_inputs(seed: int = 0) -> dict:
    key = jax.random.key(seed)
    ks = jax.random.split(key, 32)
    nrm = jax.random.normal
    f32 = jnp.float32
    qkv_w = (N_HEADS + 2 * N_KV) * HEAD_DIM
    return {
        'x': nrm(ks[0], (BATCH, SEQ, D_MODEL), f32),
        'c': nrm(ks[1], (BATCH, D_MODEL), f32),
        'ctx': nrm(ks[2], (BATCH, CTX_LEN, D_MODEL), f32),
        'c_ctx': nrm(ks[3], (D_MODEL,), f32),
        'ada_w': nrm(ks[4], (DEPTH, D_MODEL, 6 * D_MODEL), f32) * (0.5 * D_MODEL ** -0.5),
        'ada_b': nrm(ks[5], (DEPTH, 6 * D_MODEL), f32) * 0.01,
        'norm_g': 1.0 + 0.02 * nrm(ks[6], (DEPTH, 2, D_MODEL), f32),
        'a_w_in': nrm(ks[7], (N_A, D_MODEL, 2 * A_DIM), f32) * D_MODEL ** -0.5,
        'a_v_g': 1.0 + 0.02 * nrm(ks[8], (N_A, A_DIM), f32),
        'a_ws': nrm(ks[9], (N_A, A_GROUPS, CHUNK, CHUNK), f32) * CHUNK ** -0.5,
        'a_bs': 1.0 + 0.02 * nrm(ks[10], (N_A, A_GROUPS, CHUNK), f32),
        'a_w_out': nrm(ks[11], (N_A, A_DIM, D_MODEL), f32) * A_DIM ** -0.5,
        'b_w_qkv': nrm(ks[12], (N_B, D_MODEL, qkv_w), f32) * D_MODEL ** -0.5,
        'b_q_g': 1.0 + 0.02 * nrm(ks[13], (N_B, HEAD_DIM), f32),
        'b_k_g': 1.0 + 0.02 * nrm(ks[14], (N_B, HEAD_DIM), f32),
        'b_w_o': nrm(ks[15], (N_B, N_HEADS * HEAD_DIM, D_MODEL), f32) * (N_HEADS * HEAD_DIM) ** -0.5,
        'p_w': nrm(ks[16], (N_C, len(POOL_WINDOWS), POOL_GROUP, POOL_GROUP), f32) * POOL_GROUP ** -0.5,
        'p_scale': 1.0 + 0.02 * nrm(ks[17], (N_C, D_MODEL), f32),
        'f_w_gate': nrm(ks[18], (N_DENSE, D_MODEL, FFN_DIM), f32) * D_MODEL ** -0.5,
        'f_w_up': nrm(ks[19], (N_DENSE, D_MODEL, FFN_DIM), f32) * D_MODEL ** -0.5,
        'f_w_down': nrm(ks[20], (N_DENSE, FFN_DIM, D_MODEL), f32) * FFN_DIM ** -0.5,
        'm_router': nrm(ks[21], (N_MOE, D_MODEL, N_EXPERTS), f32) * D_MODEL ** -0.5,
        'm_w_gate': nrm(ks[22], (N_MOE, N_EXPERTS, D_MODEL, EXPERT_DIM), f32) * D_MODEL ** -0.5,
        'm_w_up': nrm(ks[23], (N_MOE, N_EXPERTS, D_MODEL, EXPERT_DIM), f32) * D_MODEL ** -0.5,
        'm_w_down': nrm(ks[24], (N_MOE, N_EXPERTS, EXPERT_DIM, D_MODEL), f32) * EXPERT_DIM ** -0.5,
    }


def reference(x, c, ctx, c_ctx, ada_w, ada_b, norm_g, a_w_in, a_v_g, a_ws, a_bs, a_w_out,
              b_w_qkv, b_q_g, b_k_g, b_w_o, p_w, p_scale, f_w_gate, f_w_up, f_w_down,
              m_router, m_w_gate, m_w_up, m_w_down):
    ROWS = x.shape[1] // GRID_W
    cos, sin = axial_rope_tables(ROWS)
    ctx_layers = [i for i in range(DEPTH) if i % N_MIXERS == 1]
    last_ctx_read = max(ctx_layers) if ctx_layers else -1
    xc = ctx
    for i in range(DEPTH):
        kind = i % N_MIXERS
        j = i // N_MIXERS
        adv = i < last_ctx_read
        need_ctx = adv or i == last_ctx_read
        sl, scl, gl, sfl, scfl, gfl = adaln(c, ada_w[i], ada_b[i])
        hl = modulate(x, norm_g[i, 0], sl, scl)
        if need_ctx:
            sc, scc, gc, sfc, scfc, gfc = adaln(c_ctx, ada_w[i], ada_b[i])
            hc = modulate(xc, norm_g[i, 0], sc, scc)
        if kind == 0:
            yl = chunk_mlp(hl, a_w_in[j], a_v_g[j], a_ws[j], a_bs[j], a_w_out[j])
            yc = chunk_mlp(hc, a_w_in[j], a_v_g[j], a_ws[j], a_bs[j], a_w_out[j]) if adv else None
        elif kind == 1:
            yl, yc = attention_mixer(hl, hc, b_w_qkv[j], b_q_g[j], b_k_g[j], b_w_o[j], cos, sin, adv)
        else:
            yl = pool_mixer(hl, p_w[j], p_scale[j])
            yc = pool_mixer(hc, p_w[j], p_scale[j]) if adv else None
        x = x + gl * yl
        f = i // 2
        hl2 = modulate(x, norm_g[i, 1], sfl, scfl)
        if i % 2 == 0:
            x = x + gfl * swiglu(hl2, f_w_gate[f], f_w_up[f], f_w_down[f])
        else:
            x = x + gfl * moe_swiglu(hl2, m_router[f], m_w_gate[f], m_w_up[f], m_w_down[f])
        if adv:
            xc = xc + gc * yc
            hc2 = modulate(xc, norm_g[i, 1], sfc, scfc)
            if i % 2 == 0:
                xc = xc + gfc * swiglu(hc2, f_w_gate[f], f_w_up[f], f_w_down[f])
            else:
                xc = xc + gfc * moe_swiglu(hc2, m_router[f], m_w_gate[f], m_w_up[f], m_w_down[f])
    return x
```

```cpp
#define MK_PER_PHASE 1
#include <hip/hip_runtime.h>
#include <hip/hip_bf16.h>
#include <cstdio>
#include <cstdint>
#include <cmath>

namespace pg8 {
#define PG8_LAS __attribute__((address_space(3)))
typedef unsigned short bf16_t;
typedef short bf16x8 __attribute__((ext_vector_type(8)));
typedef float f32x4 __attribute__((ext_vector_type(4)));
typedef float f32x2 __attribute__((ext_vector_type(2)));
typedef unsigned u32x4 __attribute__((ext_vector_type(4)));
typedef unsigned u32x2 __attribute__((ext_vector_type(2)));
constexpr int BM = 256, BK = 64, HALF = 128, HTB = HALF * BK * 2  , STAGE_BYTES = 8 * HTB, NXCD = 8, WGM = 8;

__host__ __device__ __forceinline__ int lds_byte(int r, int c) { const int st = (r >> 4) * 2 + (c >> 5), rr = r & 15, cc = c & 31, ob = rr * 64 + cc * 2; return st * 1024 + (ob ^ (((ob >> 9) & 1) << 5)); }
__host__ __device__ __forceinline__ void stage_rc(int b, int& R, int& C) { const int st = b / 1024, sb = b % 1024, swz = sb ^ (((sb >> 9) & 1) << 5); R = (st >> 1) * 16 + swz / 64; C = (st & 1) * 32 + (swz % 64) / 2; }
__host__ __device__ __forceinline__ int perm32(int rho) { const int n = rho >> 4, i = rho & 15; return 8 * (i >> 2) + 4 * n + (i & 3); }

struct Unit { int pm, pn, e; };
struct Gemm { const bf16_t* A; const bf16_t* Bt; int K; int lda; int a_pn_stride; size_t b_e_stride; };

struct StaticOrder {
    int nM, nN, nwg, G, c;
    __device__ void init(int nM_, int nN_, int G_, int c_) { nM = nM_; nN = nN_; nwg = nM * nN; G = G_; c = c_; }
    __device__ bool next(int i, Unit& u) const {
        const long L = (long)i * G + c; if (L >= nwg) return false;
        int wgid = (int)L; { const int q = nwg / NXCD, r = nwg % NXCD, xcd = wgid % NXCD, off = wgid / NXCD; wgid = (xcd < r ? xcd * (q + 1) : r * (q + 1) + (xcd - r) * q) + off; }
        const int nig = WGM * nN, gid = wgid / nig, fm = gid * WGM, gsz = (nM - fm) < WGM ? (nM - fm) : WGM;
        u.pm = fm + ((wgid % nig) % gsz); u.pn = (wgid % nig) / gsz; u.e = 0; return true;
    }
};
struct MoeOrder : StaticOrder {
    int tp[8];
    __device__ bool next(int i, Unit& u) const {
        if (!StaticOrder::next(i, u)) return false;
        int e = 0;
#pragma unroll
        for (int k = 1; k < 8; ++k) e += (u.pm >= tp[k]) ? 1 : 0;
        u.e = e; return true;
    }
};

__device__ __forceinline__ unsigned cvt_pk_bf16(float lo, float hi) { unsigned r; asm volatile("v_cvt_pk_bf16_f32 %0, %1, %2" : "=v"(r) : "v"(lo), "v"(hi)); return r; }
__device__ __forceinline__ float bf_lo(unsigned w) { return __builtin_bit_cast(float, w << 16); }
__device__ __forceinline__ float bf_hi(unsigned w) { return __builtin_bit_cast(float, w & 0xffff0000u); }
__device__ __forceinline__ float sigmoidf_(float x) { return __builtin_amdgcn_rcpf(1.f + __builtin_amdgcn_exp2f(-1.4426950408889634f * x)); }
__device__ __forceinline__ float gelu_tanh(float x) { const float y = 1.5957691216057308f * x * (1.f + 0.044715f * x * x); return x * sigmoidf_(y); }

typedef f32x4 AccT[2][2][4][2];

struct EpiGelu {
    static constexpr bool PERM = true;
    bf16_t* Z; float* rowss;
    __device__ __forceinline__ void operator()(const AccT& acc, const Unit& u, int wr, int wc, int fr, int fq) const {
        const int row0 = u.pm * BM + wr * 64 + fr, col0 = u.pn * BM + wc * 32 + 8 * fq; const bool isv = u.pn >= 8;
#pragma unroll
        for (int ai = 0; ai < 2; ++ai)
#pragma unroll
            for (int m = 0; m < 4; ++m) { const int row = row0 + ai * HALF + m * 16; bf16_t* rowp = Z + (size_t)row * 4096 + col0; float ss = 0.f;
#pragma unroll
                for (int bj = 0; bj < 2; ++bj) { f32x4 v0 = acc[ai][bj][m][0], v1 = acc[ai][bj][m][1];
#pragma unroll
                    for (int j = 0; j < 4; ++j) { v0[j] = gelu_tanh(v0[j]); v1[j] = gelu_tanh(v1[j]); ss += v0[j] * v0[j] + v1[j] * v1[j]; }
                    u32x4 w; w.x = cvt_pk_bf16(v0[0], v0[1]); w.y = cvt_pk_bf16(v0[2], v0[3]); w.z = cvt_pk_bf16(v1[0], v1[1]); w.w = cvt_pk_bf16(v1[2], v1[3]);
                    *(u32x4*)(rowp + bj * HALF) = w; }
                if (isv) { ss += __shfl_xor(ss, 16); ss += __shfl_xor(ss, 32); if (fq == 0) rowss[(size_t)row * 32 + (u.pn - 8) * 4 + wc] = ss; } }
    }
};
struct EpiResid {
    static constexpr bool PERM = false;
    const float* base_l; const float* base_c; float* out; const float* gate; const float* cscale;
    __device__ __forceinline__ void operator()(const AccT& acc, const Unit& u, int wr, int wc, int fr, int fq) const {
        const int row0 = u.pm * BM + wr * 64 + fr, col0 = u.pn * BM + wc * 32 + 4 * fq; const bool lat = u.pm < 64; const int bidx = lat ? (u.pm >> 4) : 4;
        f32x4 gv[2][2];
#pragma unroll
        for (int bj = 0; bj < 2; ++bj)
#pragma unroll
            for (int n = 0; n < 2; ++n) { gv[bj][n] = *(const f32x4*)(gate + bidx * 6144 + col0 + bj * HALF + n * 16); if (cscale) gv[bj][n] = gv[bj][n] * *(const f32x4*)(cscale + col0 + bj * HALF + n * 16); }
#pragma unroll
        for (int ai = 0; ai < 2; ++ai)
#pragma unroll
            for (int m = 0; m < 4; ++m) { const int row = row0 + ai * HALF + m * 16;
                const float* bp = (lat ? base_l + (size_t)row * 1024 : base_c + (size_t)(row - 16384) * 1024) + col0; float* op = out + (size_t)row * 1024 + col0;
#pragma unroll
                for (int bj = 0; bj < 2; ++bj)
#pragma unroll
                    for (int n = 0; n < 2; ++n) { const f32x4 o = *(const f32x4*)(bp + bj * HALF + n * 16) + gv[bj][n] * acc[ai][bj][m][n]; *(f32x4*)(op + bj * HALF + n * 16) = o; }
                if (m & 1) asm volatile("" ::: "memory"); }
    }
};
struct EpiSwiGLU {
    static constexpr bool PERM = true;
    bf16_t* Hd; int ldh;
    __device__ __forceinline__ void operator()(const AccT& acc, const Unit& u, int wr, int wc, int fr, int fq) const {
        const int row0 = u.pm * BM + wr * 64 + fr, col0 = u.pn * HALF + wc * 32 + 8 * fq;
#pragma unroll
        for (int ai = 0; ai < 2; ++ai)
#pragma unroll
            for (int m = 0; m < 4; ++m) { const int row = row0 + ai * HALF + m * 16; float o[8];
#pragma unroll
                for (int n = 0; n < 2; ++n)
#pragma unroll
                    for (int j = 0; j < 4; ++j) { const float gt = acc[ai][0][m][n][j], up = acc[ai][1][m][n][j]; o[4 * n + j] = gt * sigmoidf_(gt) * up; }
                u32x4 w; w.x = cvt_pk_bf16(o[0], o[1]); w.y = cvt_pk_bf16(o[2], o[3]); w.z = cvt_pk_bf16(o[4], o[5]); w.w = cvt_pk_bf16(o[6], o[7]);
                *(u32x4*)(Hd + (size_t)row * ldh + col0) = w; }
    }
};
struct EpiMoeDown {
    static constexpr bool PERM = true;
    bf16_t* Y; const float* gw;
    __device__ __forceinline__ void operator()(const AccT& acc, const Unit& u, int wr, int wc, int fr, int fq) const {
        const int row0 = u.pm * BM + wr * 64 + fr, col0 = u.pn * BM + wc * 32 + 8 * fq;
#pragma unroll
        for (int ai = 0; ai < 2; ++ai)
#pragma unroll
            for (int m = 0; m < 4; ++m) { const int row = row0 + ai * HALF + m * 16; const float s = gw[row]; bf16_t* rowp = Y + (size_t)row * 1024 + col0;
#pragma unroll
                for (int bj = 0; bj < 2; ++bj) { const f32x4 v0 = acc[ai][bj][m][0] * s, v1 = acc[ai][bj][m][1] * s;
                    u32x4 w; w.x = cvt_pk_bf16(v0[0], v0[1]); w.y = cvt_pk_bf16(v0[2], v0[3]); w.z = cvt_pk_bf16(v1[0], v1[1]); w.w = cvt_pk_bf16(v1[2], v1[3]);
                    *(u32x4*)(rowp + bj * HALF) = w; } }
    }
};
struct EpiQKV {
    static constexpr bool PERM = true;
    bf16_t* Q; bf16_t* Kb; bf16_t* Vb; const float* qg; const float* kg; const float* ctab; const float* stab; float c2;
    __device__ __forceinline__ void operator()(const AccT& acc, const Unit& u, int wr, int wc, int fr, int fq) const {
        const int row0 = u.pm * BM + wr * 64 + fr; const bool ctx = u.pm >= 64; const int pn = u.pn;
        if (ctx && pn < 4) return;
        const float* gsrc = pn < 4 ? qg : kg;
        f32x4 gq[2][2];
#pragma unroll
        for (int bj = 0; bj < 2; ++bj)
#pragma unroll
            for (int n = 0; n < 2; ++n) gq[bj][n] = *(const f32x4*)(gsrc + 32 * bj + 8 * fq + 4 * n);
        const int fo = 8 * (fq & 1); const bool hf = (fq >> 1) != 0;
#pragma unroll
        for (int ai = 0; ai < 2; ++ai)
#pragma unroll
            for (int m = 0; m < 4; ++m) { const int row = row0 + ai * HALF + m * 16;
                int kvrow; int t = 0;
                if (ctx) { const int rc = row - 16384; kvrow = (rc >> 8) * 4352 + (rc & 255); } else { t = row & 4095; kvrow = (row >> 12) * 4352 + 256 + t; }
                if (pn == 5) {
#pragma unroll
                    for (int bj = 0; bj < 2; ++bj) { const f32x4 v0 = acc[ai][bj][m][0], v1 = acc[ai][bj][m][1];
                        u32x4 w; w.x = cvt_pk_bf16(v0[0], v0[1]); w.y = cvt_pk_bf16(v0[2], v0[3]); w.z = cvt_pk_bf16(v1[0], v1[1]); w.w = cvt_pk_bf16(v1[2], v1[3]);
                        *(u32x4*)(Vb + (size_t)kvrow * 256 + wc * 64 + 32 * bj + 8 * fq) = w; }
                } else {
                    float ss = 0.f;
#pragma unroll
                    for (int bj = 0; bj < 2; ++bj)
#pragma unroll
                        for (int n = 0; n < 2; ++n)
#pragma unroll
                            for (int j = 0; j < 4; ++j) { const float a = acc[ai][bj][m][n][j]; ss += a * a; }
                    ss += __shfl_xor(ss, 16); ss += __shfl_xor(ss, 32);
                    const float rstd = __builtin_amdgcn_rsqf(ss * (1.f / 64.f) + 1e-6f);
#pragma unroll
                    for (int bj = 0; bj < 2; ++bj) { f32x4 v[2];
#pragma unroll
                        for (int n = 0; n < 2; ++n) v[n] = acc[ai][bj][m][n] * rstd * gq[bj][n];
                        if (!ctx) { const int p = bj == 0 ? (t >> 6) : (t & 63);
#pragma unroll
                            for (int n = 0; n < 2; ++n) { const f32x4 cc = *(const f32x4*)(ctab + p * 16 + fo + 4 * n), sn = *(const f32x4*)(stab + p * 16 + fo + 4 * n);
#pragma unroll
                                for (int j = 0; j < 4; ++j) { const float own = v[n][j], oth = __shfl_xor(own, 32);
                                    v[n][j] = hf ? (own * cc[j] + oth * sn[j]) : (own * cc[j] - oth * sn[j]); } } }
                        if (pn < 4) { v[0] = v[0] * c2; v[1] = v[1] * c2; }
                        u32x4 w; w.x = cvt_pk_bf16(v[0][0], v[0][1]); w.y = cvt_pk_bf16(v[0][2], v[0][3]); w.z = cvt_pk_bf16(v[1][0], v[1][1]); w.w = cvt_pk_bf16(v[1][2], v[1][3]);
                        if (pn < 4) *(u32x4*)(Q + (size_t)row * 1024 + (4 * pn + wc) * 64 + 32 * bj + 8 * fq) = w;
                        else        *(u32x4*)(Kb + (size_t)kvrow * 256 + wc * 64 + 32 * bj + 8 * fq) = w; }
                } }
    }
};

template <class Epi, class Sched, bool ALIGN_EPI = false>
__device__ __forceinline__ void gemm_phase(PG8_LAS unsigned char* lds, const int tid, const Gemm g, const Sched& S, const Epi& E) {
    const int wid = __builtin_amdgcn_readfirstlane(tid >> 6), lane = tid & 63, wr = wid >> 2, wc = wid & 3, fr = lane & 15, fq = lane >> 4;
    const int K = g.K, nt = K / BK;
    unsigned voffB[2]; int RA[2], CA[2];
#pragma unroll
    for (int i = 0; i < 2; ++i) { int R, C; stage_rc(tid * 16 + i * 8192, R, C); const int Rb = Epi::PERM ? ((R & ~31) + perm32(R & 31)) : R;
        RA[i] = R; CA[i] = C; voffB[i] = (unsigned)(Rb * K + C) * 2u; }
    const size_t kstep = (size_t)(BK * 2);
    const size_t hstep = (size_t)HALF * K * 2;
    const size_t tstep = 2 * hstep;
#define PG8_CALCA(u, v) do { _Pragma("unroll") for (int _h = 0; _h < 2; ++_h) _Pragma("unroll") for (int _i = 0; _i < 2; ++_i) \
        v[_h][_i] = (unsigned)(((u).pm * BM + _h * HALF + RA[_i]) * g.lda + (u).pn * g.a_pn_stride + CA[_i]) * 2u; } while (0)
    const unsigned ldsw = (unsigned)wid * 1024u;
    const int aoff = lds_byte(wr * 64 + fr, fq * 8), boff = lds_byte(wc * 32 + fr, fq * 8);
#define PG8_SA(b, h) (((b) * 2 + (h)) * HTB)
#define PG8_SB(b, h) ((4 + (b) * 2 + (h)) * HTB)
#define PG8_STAGE(bufoff, gbase, voff) do { _Pragma("unroll") for (int _i = 0; _i < 2; ++_i) \
        __builtin_amdgcn_global_load_lds((const unsigned*)((const char*)(gbase) + (voff)[_i]), (PG8_LAS unsigned*)(lds + (bufoff) + ldsw + _i * 8192), 16, 0, 0); } while (0)
#define PG8_LDA(dst, b, h) do { _Pragma("unroll") for (int m = 0; m < 4; ++m) _Pragma("unroll") for (int k = 0; k < 2; ++k) dst[m][k] = *(const PG8_LAS bf16x8*)(lds + PG8_SA(b, h) + aoff + m * 2048 + k * 1024); } while (0)
#define PG8_LDB(dst, b, h) do { _Pragma("unroll") for (int n = 0; n < 2; ++n) _Pragma("unroll") for (int k = 0; k < 2; ++k) dst[n][k] = *(const PG8_LAS bf16x8*)(lds + PG8_SB(b, h) + boff + n * 2048 + k * 1024); } while (0)
#define PG8_MMA(ai, bj, At, Bt) do { __builtin_amdgcn_s_setprio(1); _Pragma("unroll") for (int m = 0; m < 4; ++m) _Pragma("unroll") for (int n = 0; n < 2; ++n) _Pragma("unroll") for (int k = 0; k < 2; ++k) \
        acc[ai][bj][m][n] = __builtin_amdgcn_mfma_f32_16x16x32_bf16(Bt[n][k], At[m][k], acc[ai][bj][m][n], 0, 0, 0); __builtin_amdgcn_s_setprio(0); } while (0)
#define PG8_WAIT_V(n) asm volatile("s_waitcnt vmcnt(" #n ")" ::: "memory")
#define PG8_WAIT_L(n) asm volatile("s_waitcnt lgkmcnt(" #n ")" ::: "memory")
#define PG8_BAR __builtin_amdgcn_s_barrier()
#define PG8_SCHED __builtin_amdgcn_sched_barrier(0)
    Unit cur, nxt; int ui = 0;
    if (!S.next(0, cur)) return;
    f32x4 acc[2][2][4][2];
#pragma unroll
    for (int a = 0; a < 2; ++a)
#pragma unroll
        for (int b = 0; b < 2; ++b)
#pragma unroll
            for (int m = 0; m < 4; ++m)
#pragma unroll
                for (int n = 0; n < 2; ++n) acc[a][b][m][n] = (f32x4){0.f, 0.f, 0.f, 0.f};
    bf16x8 At[4][2], B0[2][2], B1[2][2];
    const char* const Ab = (const char*)g.A; const char* cB = (const char*)g.Bt + ((size_t)cur.e * g.b_e_stride) * 2 + (size_t)cur.pn * tstep;
    unsigned vA[2][2], vAn[2][2]; PG8_CALCA(cur, vA);
    PG8_STAGE(PG8_SB(0, 0), cB, voffB); PG8_STAGE(PG8_SB(0, 1), cB + hstep, voffB); PG8_STAGE(PG8_SA(0, 0), Ab, vA[0]); PG8_STAGE(PG8_SA(0, 1), Ab, vA[1]);
    if (wr == 1) PG8_BAR;
    PG8_WAIT_V(2); PG8_BAR;
    PG8_STAGE(PG8_SB(1, 0), cB + kstep, voffB); PG8_STAGE(PG8_SA(1, 0), Ab + kstep, vA[0]); PG8_STAGE(PG8_SB(1, 1), cB + hstep + kstep, voffB);
    PG8_WAIT_V(6); PG8_BAR;
    for (;;) {
        const bool has_next = S.next(ui + 1, nxt);
        const char* nB = has_next ? (const char*)g.Bt + ((size_t)nxt.e * g.b_e_stride) * 2 + (size_t)nxt.pn * tstep : cB;
        if (has_next) { PG8_CALCA(nxt, vAn); } else {
#pragma unroll
            for (int _h = 0; _h < 2; ++_h)
#pragma unroll
                for (int _i = 0; _i < 2; ++_i) vAn[_h][_i] = vA[_h][_i]; }
        for (int t = 0; t < nt; t += 2) {
            const bool last = (t == nt - 2);
            const char* a1 = Ab + (size_t)(t + 1) * kstep;
            const char* a2 = last ? Ab : Ab + (size_t)(t + 2) * kstep; const char* b2 = last ? nB : cB + (size_t)(t + 2) * kstep;
            const char* a3 = a2 + kstep; const char* b3 = b2 + kstep;
            unsigned w2[2][2];
#pragma unroll
            for (int _h = 0; _h < 2; ++_h)
#pragma unroll
                for (int _i = 0; _i < 2; ++_i) w2[_h][_i] = last ? vAn[_h][_i] : vA[_h][_i];
            {
            PG8_LDB(B0, 0, 0); PG8_LDB(B1, 0, 1); PG8_SCHED; PG8_LDA(At, 0, 0); PG8_STAGE(PG8_SA(1, 1), a1, vA[1]);
            PG8_WAIT_V(8); PG8_WAIT_L(0); PG8_BAR; PG8_MMA(0, 0, At, B0); PG8_MMA(0, 1, At, B1); PG8_BAR; PG8_SCHED;
            PG8_LDA(At, 0, 1); PG8_STAGE(PG8_SB(0, 0), b2, voffB); PG8_STAGE(PG8_SB(0, 1), b2 + hstep, voffB); PG8_STAGE(PG8_SA(0, 0), a2, w2[0]);
            PG8_WAIT_V(8); PG8_WAIT_L(0); PG8_BAR; PG8_MMA(1, 0, At, B0); PG8_MMA(1, 1, At, B1); PG8_BAR; PG8_SCHED;
            PG8_LDB(B0, 1, 0); PG8_LDB(B1, 1, 1); PG8_SCHED; PG8_LDA(At, 1, 0); PG8_STAGE(PG8_SA(0, 1), a2, w2[1]);
            PG8_WAIT_V(8); PG8_WAIT_L(0); PG8_BAR; PG8_MMA(0, 0, At, B0); PG8_MMA(0, 1, At, B1); PG8_BAR; PG8_SCHED;
            PG8_LDA(At, 1, 1); PG8_STAGE(PG8_SB(1, 0), b3, voffB); PG8_STAGE(PG8_SB(1, 1), b3 + hstep, voffB); PG8_STAGE(PG8_SA(1, 0), a3, w2[0]);
            PG8_WAIT_V(8); PG8_WAIT_L(0); PG8_BAR; PG8_MMA(1, 0, At, B0); PG8_MMA(1, 1, At, B1); PG8_BAR; PG8_SCHED;
            }
        }
        if constexpr (ALIGN_EPI) { if (wr == 0) PG8_BAR; }
        E(acc, cur, wr, wc, fr, fq);
        if (!has_next) break;
#pragma unroll
        for (int a = 0; a < 2; ++a)
#pragma unroll
            for (int b = 0; b < 2; ++b)
#pragma unroll
                for (int m = 0; m < 4; ++m)
#pragma unroll
                    for (int n = 0; n < 2; ++n) acc[a][b][m][n] = (f32x4){0.f, 0.f, 0.f, 0.f};
        cur = nxt; cB = nB; ++ui;
#pragma unroll
        for (int _h = 0; _h < 2; ++_h)
#pragma unroll
            for (int _i = 0; _i < 2; ++_i) vA[_h][_i] = vAn[_h][_i];
        if constexpr (ALIGN_EPI) { if (wr == 1) PG8_BAR; }
    }
    PG8_WAIT_V(0);
    if constexpr (!ALIGN_EPI) { if (wr == 0) PG8_BAR; }
    PG8_BAR;
#undef PG8_SA
#undef PG8_SB
#undef PG8_STAGE
#undef PG8_LDA
#undef PG8_LDB
#undef PG8_MMA
#undef PG8_WAIT_V
#undef PG8_WAIT_L
#undef PG8_BAR
#undef PG8_SCHED
#undef PG8_CALCA
}
}

namespace attn_body {
using bf16=__hip_bfloat16;
using bf16x8=__attribute__((ext_vector_type(8)))short;
using s16x4=__attribute__((ext_vector_type(4)))short;
using f32x16=__attribute__((ext_vector_type(16)))float;
using u32x4=__attribute__((ext_vector_type(4)))unsigned;
constexpr int BATCH=4,NHEAD=16,NKVH=4,SEQ=4096,SKV=4352,D=64,DM=NHEAD*D,KVP=NKVH*D;
constexpr int NW=8,QBLK=32,QB=QBLK*NW,KVBLK=64,NQB=SEQ/QB;
constexpr int ATTN_PITCH=DM, ATTN_UNIT_ROWS=QB;
__device__ __forceinline__ int crow(int r,int hi){return (r&3)+8*(r>>2)+4*hi;}
#define SBAR() __builtin_amdgcn_sched_barrier(0)
__device__ __forceinline__ void cmask(f32x16&p0,f32x16&p1,int jb,int qrel,int hi){
  const float NEG=-INFINITY; int kb=64*jb+4*hi;
  #pragma unroll
  for(int r=0;r<16;++r){int kv=kb+(r&3)+8*(r>>2); if(kv>qrel)p0[r]=NEG; if(kv+32>qrel)p1[r]=NEG;}
}

constexpr int NSLOT=3, SLOTB=8192;
constexpr int LDS_K=0, LDS_V=NSLOT*SLOTB, LDS_WS=2*NSLOT*SLOTB, LDS_OST=LDS_WS+NW*64*4, LDS_BYTES=LDS_OST+NW*4096;
constexpr float C2=0.125f*1.4426950408889634f;
__device__ __forceinline__ void glds16(const void*gsrc,unsigned lds_dst){unsigned keep;
  asm volatile("s_mov_b32 %0, m0\n\ts_mov_b32 m0, %2\n\ts_nop 0\n\tglobal_load_lds_dwordx4 %1, off\n\ts_mov_b32 m0, %0":"=&s"(keep):"v"(gsrc),"s"(lds_dst):"memory");}
__device__ __forceinline__ float max3f(float a,float b,float c){float r;asm("v_max3_f32 %0, %1, %2, %3":"=v"(r):"v"(a),"v"(b),"v"(c));return r;}
__device__ __forceinline__ float max2f(float a,float b){float r;asm("v_max_f32_e32 %0, %1, %2":"=v"(r):"v"(a),"v"(b));return r;}
__device__ __forceinline__ float fadd_s(float a,float b){float r;asm("v_add_f32_e32 %0, %1, %2":"=v"(r):"v"(a),"v"(b));return r;}
__device__ __forceinline__ float fsub_s(float a,float b){float r;asm("v_sub_f32_e32 %0, %1, %2":"=v"(r):"v"(a),"v"(b));return r;}
typedef float f32x2_t __attribute__((ext_vector_type(2))); typedef __bf16 bf16x2_t __attribute__((ext_vector_type(2)));
__device__ __forceinline__ unsigned cvtpk_s(float lo,float hi){f32x2_t v={lo,hi};bf16x2_t b=__builtin_convertvector(v,bf16x2_t);return __builtin_bit_cast(unsigned,b);}
#define WAIT_BAR(N) asm volatile("s_waitcnt vmcnt(" #N ") lgkmcnt(0)\n\ts_barrier":::"memory")

__device__ __forceinline__ void qkt(f32x16&p0,f32x16&p1,const char*Kslot,const bf16x8*qr,const f32x16&negm,int r32,int hi){
  const char*kb=Kslot+hi*1024+r32*16;
  #pragma unroll
  for(int d0=0;d0<4;++d0){
    const bf16x8 b0=*reinterpret_cast<const bf16x8*>(kb+d0*2048);
    const bf16x8 b1=*reinterpret_cast<const bf16x8*>(kb+d0*2048+512);
    if(d0==0){p0=__builtin_amdgcn_mfma_f32_32x32x16_bf16(b0,qr[0],negm,0,0,0);p1=__builtin_amdgcn_mfma_f32_32x32x16_bf16(b1,qr[0],negm,0,0,0);}
    else{p0=__builtin_amdgcn_mfma_f32_32x32x16_bf16(b0,qr[d0],p0,0,0,0);p1=__builtin_amdgcn_mfma_f32_32x32x16_bf16(b1,qr[d0],p1,0,0,0);}}
}
typedef __attribute__((address_space(3))) const char* lds_cptr;
typedef short v4i16_t __attribute__((ext_vector_type(4)));
__device__ __forceinline__ void kload8(bf16x8*kf,lds_cptr kp){
  kf[0]=*(const __attribute__((address_space(3))) bf16x8*)(kp);      kf[1]=*(const __attribute__((address_space(3))) bf16x8*)(kp+512);
  kf[2]=*(const __attribute__((address_space(3))) bf16x8*)(kp+2048); kf[3]=*(const __attribute__((address_space(3))) bf16x8*)(kp+2560);
  kf[4]=*(const __attribute__((address_space(3))) bf16x8*)(kp+4096); kf[5]=*(const __attribute__((address_space(3))) bf16x8*)(kp+4608);
  kf[6]=*(const __attribute__((address_space(3))) bf16x8*)(kp+6144); kf[7]=*(const __attribute__((address_space(3))) bf16x8*)(kp+6656);
}
__device__ __forceinline__ void kload2(bf16x8*kf,lds_cptr kp,int j){ kf[2*j]=*(const __attribute__((address_space(3))) bf16x8*)(kp+j*2048); kf[2*j+1]=*(const __attribute__((address_space(3))) bf16x8*)(kp+j*2048+512); }
__device__ __forceinline__ s16x4 vtr(lds_cptr p){ return __builtin_bit_cast(s16x4,__builtin_amdgcn_ds_read_tr16_b64_v4i16((__attribute__((address_space(3))) v4i16_t*)p)); }
__device__ __forceinline__ float rowmax(const f32x16&p0,const f32x16&p1){
  float a=max3f(p0[0],p0[1],p1[0]),b=max3f(p0[2],p0[3],p1[1]);a=max3f(a,p1[2],p1[3]);
  #pragma unroll
  for(int r=4;r<16;r+=4){a=max3f(a,p0[r],p0[r+1]);b=max3f(b,p0[r+2],p0[r+3]);a=max3f(a,p1[r],p1[r+1]);b=max3f(b,p1[r+2],p1[r+3]);}
  const float m=max2f(a,b);
  auto rr=__builtin_amdgcn_permlane32_swap(__float_as_uint(m),__float_as_uint(m),false,false);
  return max2f(__uint_as_float(rr[0]),__uint_as_float(rr[1]));
}
__device__ __forceinline__ void pv(f32x16*o,int vb,bf16x8 pa0,bf16x8 pa1,bf16x8 pa2,bf16x8 pa3){
  #pragma unroll
  for(int d0=0;d0<2;++d0){s16x4 lo[4],hi[4];
    #pragma unroll
    for(int ks=0;ks<4;++ks){
      asm volatile("ds_read_b64_tr_b16 %0,%1 offset:%c2":"=&v"(lo[ks]):"v"(vb),"i"(d0*4096+ks*1024):"memory");
      asm volatile("ds_read_b64_tr_b16 %0,%1 offset:%c2":"=&v"(hi[ks]):"v"(vb),"i"(d0*4096+ks*1024+512):"memory");}
    asm volatile("s_waitcnt lgkmcnt(0)":::"memory");SBAR();
    #define PK(k) (bf16x8){lo[k][0],lo[k][1],lo[k][2],lo[k][3],hi[k][0],hi[k][1],hi[k][2],hi[k][3]}
    o[d0]=__builtin_amdgcn_mfma_f32_32x32x16_bf16(pa0,PK(0),o[d0],0,0,0);
    o[d0]=__builtin_amdgcn_mfma_f32_32x32x16_bf16(pa1,PK(1),o[d0],0,0,0);
    o[d0]=__builtin_amdgcn_mfma_f32_32x32x16_bf16(pa2,PK(2),o[d0],0,0,0);
    o[d0]=__builtin_amdgcn_mfma_f32_32x32x16_bf16(pa3,PK(3),o[d0],0,0,0);
    #undef PK
  }
}

#ifndef ATTN_STORE16
#define ATTN_STORE16(p,v) (*(u32x4*)(p)=(v))
#endif
template<int THRL> __device__ __forceinline__ void attn_unit(const int tid,int b,int h,int qb,const bf16*Q,const bf16*__restrict__ K,const bf16*__restrict__ V,bf16*O,char*shm){
  const int lane=tid&63,r32=lane&31,hi=lane>>5; const int wid=__builtin_amdgcn_readfirstlane(tid>>6);
  const long rowbase=(long)b*SEQ; const int q0=qb*QB;
  const bf16*Qw=Q+(rowbase+q0+wid*QBLK)*DM+h*D;
  const bf16*Kh=K+(long)b*SKV*KVP+(h>>2)*D,*Vh=V+(long)b*SKV*KVP+(h>>2)*D;
  const unsigned lds0=(unsigned)(uintptr_t)shm;
  float*wsf=(float*)(shm+LDS_WS)+wid*64;
  const bf16*ksrc=Kh+(long)lane*KVP+wid*8;
  const bf16*vsrc=Vh+(long)(16*(wid&3)+(lane>>2))*KVP+(wid>>2)*32+(lane&3)*8;
  const unsigned kdst=lds0+LDS_K+wid*1024, vdst=lds0+LDS_V+wid*1024;
  #define DMA_K(t,slot) glds16(ksrc+(long)(t)*KVBLK*KVP,(unsigned)__builtin_amdgcn_readfirstlane(kdst+(slot)))
  #define DMA_V(t,slot) glds16(vsrc+(long)(t)*KVBLK*KVP,(unsigned)__builtin_amdgcn_readfirstlane(vdst+(slot)))
  const int vb0=(int)(lds0+LDS_V)+((lane>>4)&1)*32+(lane&3)*8+(4*hi+((lane&15)>>2))*64;
  const char*Kbase=shm+LDS_K; bf16x8 kf[8];
  const lds_cptr shm3=(lds_cptr)shm; const lds_cptr kp0=shm3+LDS_K+hi*1024+r32*16; const lds_cptr vp0=shm3+LDS_V+((lane>>4)&1)*32+(lane&3)*8+(4*hi+((lane&15)>>2))*64;
  int NT=SKV/KVBLK; asm volatile("":"+s"(NT));
  DMA_K(0,0);DMA_V(0,0);DMA_K(1,SLOTB);
  bf16x8 qr[4];
  #pragma unroll
  for(int d0=0;d0<4;++d0)qr[d0]=*reinterpret_cast<const bf16x8*>(&Qw[(long)r32*DM+d0*16+hi*8]);
  float mhat=0.f,l_reg=0.f;f32x16 o[2];o[0]=f32x16{};o[1]=f32x16{};f32x16 negm=f32x16{};asm volatile("":"+v"(negm));
  #define CMASK(P0,P1,t) do{}while(0)
  bool resc=false;
  #define START(P0,P1) do{ const float rm=rowmax(P0,P1); resc=false; \
    { const float dl=rm; mhat=fadd_s(mhat,dl); \
      _Pragma("unroll") for(int r=0;r<16;++r){P0[r]=fsub_s(P0[r],dl);P1[r]=fsub_s(P1[r],dl);} \
      _Pragma("unroll") for(int r=0;r<16;++r)negm[r]=-mhat; asm volatile("":"+v"(negm)); } \
    _Pragma("unroll") for(int r=0;r<16;++r)P0[r]=__builtin_amdgcn_exp2f(P0[r]); }while(0)
  #define RESC() do{ if(resc){ asm volatile("s_waitcnt lgkmcnt(0)":::"memory"); \
      _Pragma("unroll") for(int d_=0;d_<2;++d_) _Pragma("unroll") for(int r=0;r<16;++r)o[d_][r]*=wsf[crow(r,hi)]; } }while(0)
  f32x16 pA0,pA1,pB0,pB1;
  int sl_prev=0,sl_cur=0,sl_next=SLOTB;
  #define ROT() do{sl_prev=sl_cur;sl_cur=sl_next;sl_next=(sl_next==(NSLOT-1)*SLOTB)?0:sl_next+SLOTB;}while(0)
  DMA_K(2,2*SLOTB);
  WAIT_BAR(3);
  qkt(pA0,pA1,Kbase,qr,negm,r32,hi);asm volatile("s_nop 15\n\ts_nop 7":"+v"(pA0),"+v"(pA1));CMASK(pA0,pA1,0);
  START(pA0,pA1);
  _Pragma("unroll") for(int r=0;r<16;++r)pA1[r]=__builtin_amdgcn_exp2f(pA1[r]);
  WAIT_BAR(0);
  DMA_K(3,0);DMA_V(1,SLOTB);
  ROT();
  kload8(kf,kp0+sl_cur);
  WAIT_BAR(2);
  s16x4 vlo[8],vhi[8]; u32x4 pw0,pw1,pw2,pw3;
  #define PKW(P,B) cvtpk_s(P[B],P[B+1])
  #define PAF(k) __builtin_bit_cast(bf16x8,pw##k)
  #define VFR(i) (bf16x8){vlo[i][0],vlo[i][1],vlo[i][2],vlo[i][3],vhi[i][0],vhi[i][1],vhi[i][2],vhi[i][3]}
  #define PIN(x) asm volatile("":"+v"(x))
  #define MX3(a,b,c) __builtin_fmaxf(__builtin_fmaxf((a),(b)),(c))
  #define GAPA(MF,A0,A1,A2,A3,W0,W1,PW) do{ MF; sacc+=A0; sacc+=A1; sacc+=A2; sacc+=A3; PIN(sacc); W0; W1; PIN(PW); SBAR(); }while(0)
  #define EX(v) __builtin_amdgcn_exp2f(v)
  #define GAPB(MF,X,B) do{ MF; X[B]=EX(X[B]); X[B+1]=EX(X[B+1]); X[B+2]=EX(X[B+2]); X[B+3]=EX(X[B+3]); PIN(X); SBAR(); }while(0)
  #define VRD(i) do{ vlo[i]=vtr(vp_+(((i)>>2)*4096+((i)&3)*1024)); vhi[i]=vtr(vp_+(((i)>>2)*4096+((i)&3)*1024+512)); }while(0)
  #define KRD(G,j) do{ if(G){ kload2(kf,kp0+sl_next,j); SBAR(); } }while(0)
  #define STEP(C0,C1,P0,P1,t,GK,GV,GL) do{ SBAR(); \
    const lds_cptr vp_=vp0+sl_prev; \
    VRD(0); SBAR(); float sacc=(P0[0]+P0[1]); \
    GAPA(C0=__builtin_amdgcn_mfma_f32_32x32x16_bf16(kf[0],qr[0],negm,0,0,0), P0[2],P0[3],P0[4],P0[5],     pw0[0]=PKW(P0,0), pw0[1]=PKW(P0,2), pw0); \
    VRD(4); SBAR(); GAPA(C1=__builtin_amdgcn_mfma_f32_32x32x16_bf16(kf[1],qr[0],negm,0,0,0), P0[6],P0[7],P0[8],P0[9],     pw0[2]=PKW(P0,4), pw0[3]=PKW(P0,6), pw0); \
    VRD(1); SBAR(); GAPA(C0=__builtin_amdgcn_mfma_f32_32x32x16_bf16(kf[2],qr[1],C0,0,0,0),   P0[10],P0[11],P0[12],P0[13], pw1[0]=PKW(P0,8), pw1[1]=PKW(P0,10), pw1); \
    VRD(5); SBAR(); GAPA(C1=__builtin_amdgcn_mfma_f32_32x32x16_bf16(kf[3],qr[1],C1,0,0,0),   P0[14],P0[15],P1[0],P1[1],   pw1[2]=PKW(P0,12),pw1[3]=PKW(P0,14), pw1); \
    VRD(2); SBAR(); GAPA(C0=__builtin_amdgcn_mfma_f32_32x32x16_bf16(kf[4],qr[2],C0,0,0,0),   P1[2],P1[3],P1[4],P1[5],     pw2[0]=PKW(P1,0), pw2[1]=PKW(P1,2), pw2); \
    VRD(6); SBAR(); GAPA(C1=__builtin_amdgcn_mfma_f32_32x32x16_bf16(kf[5],qr[2],C1,0,0,0),   P1[6],P1[7],P1[8],P1[9],     pw2[2]=PKW(P1,4), pw2[3]=PKW(P1,6), pw2); \
    VRD(3); SBAR(); GAPA(C0=__builtin_amdgcn_mfma_f32_32x32x16_bf16(kf[6],qr[3],C0,0,0,0),   P1[10],P1[11],P1[12],P1[13], pw3[0]=PKW(P1,8), pw3[1]=PKW(P1,10), pw3); \
    VRD(7); SBAR(); GAPA(C1=__builtin_amdgcn_mfma_f32_32x32x16_bf16(kf[7],qr[3],C1,0,0,0),   P1[14],P1[15],0.f,0.f,       pw3[2]=PKW(P1,12),pw3[3]=PKW(P1,14), pw3); \
    l_reg+=sacc; \
    if(GK){DMA_K((t)+3,sl_cur);} if(GV){DMA_V((t)+1,sl_next);} \
    CMASK(C0,C1,t); \
    { float a=MX3(C0[0],C0[1],C1[0]),b=MX3(C0[2],C0[3],C1[1]); a=MX3(a,C1[2],C1[3]); \
      _Pragma("unroll") for(int r=4;r<16;r+=4){a=MX3(a,C0[r],C0[r+1]);b=MX3(b,C0[r+2],C0[r+3]);a=MX3(a,C1[r],C1[r+1]);b=MX3(b,C1[r+2],C1[r+3]);} \
      float rm=__builtin_fmaxf(a,b); { auto rr=__builtin_amdgcn_permlane32_swap(__float_as_uint(rm),__float_as_uint(rm),false,false); rm=__builtin_fmaxf(__uint_as_float(rr[0]),__uint_as_float(rr[1])); } \
      resc=false; \
      if(__builtin_expect(__any(rm>(float)THRL),0)){ const float dl=__builtin_fmaxf(rm,0.f); mhat+=dl; \
        _Pragma("unroll") for(int r=0;r<16;++r){C0[r]-=dl;C1[r]-=dl;} \
        _Pragma("unroll") for(int r=0;r<16;++r)negm[r]=-mhat; asm volatile("":"+v"(negm)); \
        const float f=__builtin_amdgcn_exp2f(-dl); l_reg*=f; if(hi==0)wsf[r32]=f; resc=true; } } \
    SBAR(); \
    GAPB(o[0]=__builtin_amdgcn_mfma_f32_32x32x16_bf16(PAF(0),VFR(0),o[0],0,0,0), C0,0); \
    GAPB(o[1]=__builtin_amdgcn_mfma_f32_32x32x16_bf16(PAF(0),VFR(4),o[1],0,0,0), C0,4); \
    KRD(GL,0); GAPB(o[0]=__builtin_amdgcn_mfma_f32_32x32x16_bf16(PAF(1),VFR(1),o[0],0,0,0), C0,8); \
    KRD(GL,1); GAPB(o[1]=__builtin_amdgcn_mfma_f32_32x32x16_bf16(PAF(1),VFR(5),o[1],0,0,0), C0,12); \
    KRD(GL,2); GAPB(o[0]=__builtin_amdgcn_mfma_f32_32x32x16_bf16(PAF(2),VFR(2),o[0],0,0,0), C1,0); \
    KRD(GL,3); GAPB(o[1]=__builtin_amdgcn_mfma_f32_32x32x16_bf16(PAF(2),VFR(6),o[1],0,0,0), C1,4); \
    GAPB(o[0]=__builtin_amdgcn_mfma_f32_32x32x16_bf16(PAF(3),VFR(3),o[0],0,0,0), C1,8); \
    GAPB(o[1]=__builtin_amdgcn_mfma_f32_32x32x16_bf16(PAF(3),VFR(7),o[1],0,0,0), C1,12); \
    }while(0)
  int t=1;
  #undef CMASK
  #define CMASK(P0,P1,t) do{}while(0)
  for(;t+5<NT;t+=2){
    STEP(pB0,pB1,pA0,pA1,t,true,true,true);     WAIT_BAR(2); RESC(); ROT();
    STEP(pA0,pA1,pB0,pB1,t+1,true,true,true);   WAIT_BAR(2); RESC(); ROT();
  }
  #undef CMASK
  #define CMASK(P0,P1,t) do{}while(0)
  #define ENDW(tt) do{ if((tt)+3<NT){WAIT_BAR(2);} else if((tt)+2<NT){WAIT_BAR(1);} else {WAIT_BAR(0);} }while(0)
  for(;t+1<NT;t+=2){
    STEP(pB0,pB1,pA0,pA1,t,(t+3<NT),(t+1<NT),(t+1<NT));       ENDW(t);   RESC(); ROT();
    STEP(pA0,pA1,pB0,pB1,t+1,(t+4<NT),(t+2<NT),(t+2<NT));     ENDW(t+1); RESC(); ROT();
  }
  STEP(pB0,pB1,pA0,pA1,NT-1,false,false,false); RESC();
  { float sacc=pB0[0]+pB0[1]; _Pragma("unroll") for(int r=2;r<16;++r)sacc+=pB0[r]; _Pragma("unroll") for(int r=0;r<16;++r)sacc+=pB1[r]; l_reg+=sacc;
    pw0=(u32x4){PKW(pB0,0),PKW(pB0,2),PKW(pB0,4),PKW(pB0,6)};pw1=(u32x4){PKW(pB0,8),PKW(pB0,10),PKW(pB0,12),PKW(pB0,14)};pw2=(u32x4){PKW(pB1,0),PKW(pB1,2),PKW(pB1,4),PKW(pB1,6)};pw3=(u32x4){PKW(pB1,8),PKW(pB1,10),PKW(pB1,12),PKW(pB1,14)};
    SBAR(); pv(o,vb0+sl_cur,PAF(0),PAF(1),PAF(2),PAF(3)); }
  #undef PKW
  #undef PAF
  #undef VFR
  #undef PIN
  #undef MX3
  #undef GAPA
  #undef GAPB
  #undef EX
  #undef VRD
  #undef KRD
  #undef STEP
  #undef ENDW
  {auto rr=__builtin_amdgcn_permlane32_swap(__float_as_uint(l_reg),__float_as_uint(l_reg),false,false);l_reg=__uint_as_float(rr[0])+__uint_as_float(rr[1]);}
  if(hi==0)wsf[32+r32]=l_reg;asm volatile("s_waitcnt lgkmcnt(0)":::"memory");
  float rli[16];
  #pragma unroll
  for(int r=0;r<16;++r)rli[r]=__builtin_amdgcn_rcpf(wsf[32+crow(r,hi)]);
  bf16*Ow=O+(rowbase+q0+wid*QBLK)*DM+h*D;
  { bf16*stg=(bf16*)(shm+LDS_OST)+wid*2048;
    #pragma unroll
    for(int r=0;r<16;++r){const int orow=crow(r,hi);
      #pragma unroll
      for(int d0=0;d0<2;++d0)stg[orow*64+d0*32+r32]=__float2bfloat16(o[d0][r]*rli[r]);}
    asm volatile("s_waitcnt lgkmcnt(0)":::"memory");
    #pragma unroll
    for(int i=0;i<4;++i){const int row=i*8+(lane>>3),ch=lane&7; const u32x4 v=*(const u32x4*)(stg+row*64+ch*8); ATTN_STORE16(Ow+(long)row*DM+ch*8,v);} }
  asm volatile("s_waitcnt lgkmcnt(0)\n\ts_barrier":::"memory");
  #undef DMA_K
  #undef DMA_V
  #undef CMASK
  #undef START
  #undef RESC
  #undef ROT
}
constexpr int ATTN_LDS_BYTES=LDS_BYTES;
struct AttnTensors { const bf16* Q; const bf16* K; const bf16* V; bf16* O; };
struct AttnUnit { int bh; int qb; };
struct StaticOrder {
  int vcu,G,per;
  __device__ __forceinline__ explicit StaticOrder(int grid,int vcu_):vcu(vcu_),G(grid),per((BATCH*NHEAD*NQB+grid-1)/grid){}
  __device__ __forceinline__ bool next(int i,AttnUnit&u)const{ if(i>=per)return false; const int idx=vcu*per+i; if(idx>=BATCH*NHEAD*NQB)return false; u.bh=idx/NQB; u.qb=idx%NQB; return true; }
  __device__ __forceinline__ void a_ready(const AttnUnit&)const{}
  __device__ __forceinline__ void done(const AttnUnit&)const{}
};
template<class Sched,int THRL=8> __device__ __forceinline__ void attn_phase(const int tid,char*lds,const AttnTensors&T,const Sched&S){
  AttnUnit u;
  for(int i=0;S.next(i,u);++i){ S.a_ready(u); attn_unit<THRL>(tid,u.bh/NHEAD,u.bh%NHEAD,u.qb,T.Q,T.K,T.V,T.O,lds); S.done(u); }
}
#undef SBAR
#undef WAIT_BAR
}

constexpr int NWAVES = 8;
#ifndef MK_PER_PHASE
#define MK_PER_PHASE 0
#endif
#ifndef DBG_STOP
#define DBG_STOP 99
#endif
constexpr int NPH = 32;

constexpr int D = 1024, NB = 4, SEQ = 4096, TL = NB * SEQ, CTXL = 256, TC = NB * CTXL, TT = TL + TC;
constexpr int ADIM = 2048, FF = 2816, ED = 3584, NE = 8, QKVW = 1536, SKV = CTXL + SEQ;
constexpr int MPAD = 136 * 256;
constexpr float EPS = 1e-6f;

constexpr size_t MiB = 1u << 20, KiB = 1u << 10;
constexpr size_t WS_CTL = 0, CTL_ZERO_BYTES = 64 * KiB;
constexpr size_t WS_MODS = 1 * MiB;
constexpr size_t WS_TAB = 2 * MiB;
constexpr size_t WS_TOKE = 2 * MiB + 64 * KiB, WS_TOKS = WS_TOKE + 128 * KiB, WS_TOKG = WS_TOKS + 128 * KiB, WS_PROW = WS_TOKG + 128 * KiB, WS_GW = WS_PROW + 128 * KiB;
constexpr size_t WS_RSP = 4 * MiB;
constexpr size_t W_IN = 8 * MiB, W_OUT = 24 * MiB, W_QKV = 32 * MiB, W_O = 35 * MiB, W_P = 37 * MiB, W_GU = 38 * MiB, W_DN = 60 * MiB, M_GU = 71 * MiB, M_DN = 295 * MiB;
constexpr size_t WS_XS = 407 * MiB, WS_H = 475 * MiB, WS_BIG = 509 * MiB, WS_R2 = 747 * MiB, WS_END = 815 * MiB;
constexpr size_t WS_MODP = WS_R2;
static_assert(WS_GW + MPAD * 4 <= 4 * MiB && WS_MODS + 4 * 5 * 6144 * 4 <= WS_TAB && WS_RSP + (size_t)TT * 32 * 4 <= W_IN, "small-buffer map");
static_assert(M_DN + (size_t)16 * D * ED * 2 == WS_XS && WS_XS + (size_t)TT * D * 4 == WS_H && WS_H + (size_t)TT * D * 2 == WS_BIG && WS_BIG + (size_t)MPAD * ED * 2 == WS_R2 && WS_R2 + (size_t)MPAD * D * 2 == WS_END, "d_ws map");
constexpr int CW_TMO = 0, CW_CODE = 1, CW_BAR = 4096, CW_CNT = 8192;

constexpr int RING_OFF = 0, RING_BYTES = 131072;
constexpr int LDSCTL_OFF = RING_BYTES, MISC_OFF = LDSCTL_OFF + 320;
constexpr int LDS_BYTES = 147456;
static_assert(MISC_OFF + 128 <= LDS_BYTES, "LDS map");

#define GAS __attribute__((address_space(1)))
#define LAS __attribute__((address_space(3)))
typedef unsigned short bf16;
typedef unsigned v4u __attribute__((ext_vector_type(4)));
typedef float f32x4 __attribute__((ext_vector_type(4)));
typedef short bf16x8 __attribute__((ext_vector_type(8)));
typedef GAS unsigned gu32;
typedef GAS unsigned long long gu64;
#define RLX_AGENT __ATOMIC_RELAXED, __HIP_MEMORY_SCOPE_AGENT
#define LDS_WAIT() asm volatile("s_waitcnt lgkmcnt(0)" ::: "memory")
#define VM_WAIT() asm volatile("s_waitcnt vmcnt(0)" ::: "memory")
__device__ __forceinline__ unsigned long long rt() { return __builtin_amdgcn_s_memrealtime(); }
__device__ __forceinline__ unsigned f2bf(float f) { unsigned u = __builtin_bit_cast(unsigned, f); return (u + 0x7fffu + ((u >> 16) & 1u)) >> 16; }
__device__ __forceinline__ unsigned pk2(float lo, float hi) { return f2bf(lo) | (f2bf(hi) << 16); }

#define XB_TMO      128
#define XB_XCNT(j)  (256  + 64 * (j))
#define XB_XSUB(j)  (1280 + 64 * (j))
#define XB_XGEN(j)  (2304 + 64 * (j))
#define XB_TOP      3328
#define XB_TOPGEN   3392
#define XCD_BAR_WORDS 3456
#define XB_SPIN_CAP (1u << 18)

__device__ __forceinline__ unsigned xb_ld(unsigned* p)              { return __hip_atomic_load(p, __ATOMIC_RELAXED, __HIP_MEMORY_SCOPE_AGENT); }
__device__ __forceinline__ unsigned xb_add(unsigned* p, unsigned v) { return __hip_atomic_fetch_add(p, v, __ATOMIC_RELAXED, __HIP_MEMORY_SCOPE_AGENT); }
__device__ __forceinline__ unsigned xb_xcc_id() { return (unsigned)__builtin_amdgcn_s_getreg((3 << 11) | 20) & 0xFu; }
#define XB_SPIN(cond, bar) do { unsigned _sp = 0; while (cond) { __builtin_amdgcn_s_sleep(1); \
    if ((++_sp & 255u) == 0u) { if (xb_ld(&(bar)[XB_TMO])) break; if (_sp > XB_SPIN_CAP) { atomicAdd(&(bar)[XB_TMO], 1u); break; } } } } while (0)

struct XcdBarrier {
    unsigned* bar; unsigned x;
    volatile LAS unsigned* st;
};

__device__ __forceinline__ XcdBarrier xcd_barrier_post(unsigned* bar, volatile LAS unsigned* st, const int tid) {
    XcdBarrier b; b.bar = bar; b.x = xb_xcc_id(); b.st = st;
    if (tid == 0) (void)xb_add(&bar[XB_XCNT(b.x)], 1u);
    return b;
}
__device__ __forceinline__ void xcd_barrier_complete(unsigned* bar, unsigned x, unsigned& nloc, unsigned& nx) {
    const unsigned G = gridDim.x * gridDim.y * gridDim.z;
    unsigned sum, cnt, mine, sp = 0u;
    for (;;) {
        sum = 0u; cnt = 0u; mine = 0u;
#pragma unroll
        for (unsigned j = 0; j < 16; ++j) { const unsigned c = xb_ld(&bar[XB_XCNT(j)]); sum += c; cnt += (c > 0u) ? 1u : 0u; mine = (j == x) ? c : mine; }
        if (sum == G) break;
        __builtin_amdgcn_s_sleep(1);
        if ((++sp & 255u) == 0u) { if (xb_ld(&bar[XB_TMO])) break; if (sp > XB_SPIN_CAP) { atomicAdd(&bar[XB_TMO], 1u); break; } }
    }
    nloc = mine > 0u ? mine : 1u; nx = cnt > 0u ? cnt : 1u;
}

__device__ __forceinline__ void xcd_barrier(const XcdBarrier& b, const int tid) {
    asm volatile("s_waitcnt vmcnt(0)" ::: "memory");
    __syncthreads();
    if (tid == 0) {
        unsigned* bar = b.bar;
        __builtin_amdgcn_s_waitcnt(0);
        unsigned nloc = b.st[0], nx = b.st[1];
        if (nloc == 0u) { xcd_barrier_complete(bar, b.x, nloc, nx); b.st[0] = nloc; b.st[1] = nx; }
        const unsigned old = xb_add(&bar[XB_XSUB(b.x)], 1u);
        const unsigned gen = old / nloc;
        if (old + 1u == (gen + 1u) * nloc) {
            __builtin_amdgcn_fence(__ATOMIC_RELEASE, "agent");
            asm volatile("s_waitcnt vmcnt(0)" ::: "memory");
            const unsigned og = xb_add(&bar[XB_TOP], 1u);
            const unsigned tg = og / nx;
            if (og + 1u == (tg + 1u) * nx) xb_add(&bar[XB_TOPGEN], 1u);
            else XB_SPIN(xb_ld(&bar[XB_TOPGEN]) == tg, bar);
            __builtin_amdgcn_fence(__ATOMIC_ACQUIRE, "agent");
            xb_add(&bar[XB_XGEN(b.x)], 1u);
            asm volatile("s_waitcnt vmcnt(0)" ::: "memory");
        } else {
            XB_SPIN(xb_ld(&bar[XB_XGEN(b.x)]) == gen, bar);
            __builtin_amdgcn_fence(__ATOMIC_ACQUIRE, "agent");
            asm volatile("s_waitcnt vmcnt(0)" ::: "memory");
        }
    }
    __syncthreads();
}


typedef pg8::f32x2 f32x2; typedef pg8::u32x2 u32x2; typedef pg8::u32x4 u32x4;
using pg8::cvt_pk_bf16; using pg8::bf_lo; using pg8::bf_hi;

__device__ __forceinline__ float wave_sum(float v) {
#pragma unroll
    for (int o = 1; o < 64; o <<= 1) v += __shfl_xor(v, o);
    return v;
}

__device__ __forceinline__ void transpose_item(const float* __restrict__ W, int K, int N, bf16* WT, int kb, int nb, int prow0, LAS float* scr, int lane) {
    const int k0 = 64 * kb, n0 = 32 * nb;
#pragma unroll 8
    for (int i = 0; i < 32; ++i) { const int kk = 2 * i + (lane >> 5); scr[kk * 33 + (lane & 31)] = W[(size_t)(k0 + kk) * N + n0 + (lane & 31)]; }
    LDS_WAIT(); asm volatile("" ::: "memory");
    const int c = lane & 7;
#pragma unroll
    for (int j = 0; j < 4; ++j) { const int n = (lane >> 3) + 8 * j; const LAS float* s = scr + (8 * c) * 33 + n;
        v4u o; o.x = pk2(s[0 * 33], s[1 * 33]); o.y = pk2(s[2 * 33], s[3 * 33]); o.z = pk2(s[4 * 33], s[5 * 33]); o.w = pk2(s[6 * 33], s[7 * 33]);
        *(GAS v4u*)(WT + (size_t)(prow0 + n) * K + k0 + 8 * c) = o; }
    LDS_WAIT(); asm volatile("" ::: "memory");
}
__device__ __forceinline__ int gu_row(int c0, int up) { return (c0 >> 7) * 256 + (c0 & 127) + (up ? 128 : 0); }
__device__ __forceinline__ int qkv_row(int l0) { const int pn = l0 >> 8, wc = (l0 & 255) >> 6, bj = (l0 & 63) >> 5; return 256 * pn + 128 * bj + 32 * wc; }

struct In {
    const float *x, *c, *ctx, *c_ctx, *ada_w, *ada_b, *norm_g, *a_w_in, *a_v_g, *a_ws, *a_bs, *a_w_out, *b_w_qkv, *b_q_g, *b_k_g, *b_w_o, *p_w, *p_scale,
                *f_w_gate, *f_w_up, *f_w_down, *m_router, *m_w_gate, *m_w_up, *m_w_down;
};

__device__ __forceinline__ void p1_convert(const In& I, unsigned char* ws, LAS unsigned char* lds, int lane, int wave, int G) {
    LAS float* scr = (LAS float*)(lds + RING_OFF + wave * 16384);
    const int gw = (int)blockIdx.x * NWAVES + wave, NGW = G * NWAVES;
    for (int it = gw; it < 4 * 5 * 6144 / 256; it += NGW) { const int idx = it * 256 + lane * 4, i = idx / (5 * 6144), col = idx % 6144;
        f32x4 a = *(const f32x4*)(I.ada_b + i * 6144 + col);
#pragma unroll
        for (int kc = 0; kc < 8; ++kc) a = a + *(const f32x4*)((const float*)(ws + WS_MODP) + (size_t)kc * (4 * 5 * 6144) + idx);
        *(f32x4*)((float*)(ws + WS_MODS) + idx) = a; }
    constexpr int IPM = 1792, IPE = 3 * IPM, NMOE = 16 * IPE;
    for (int it = gw; it < NMOE; it += NGW) {
        const int le = it / IPE, r = it - le * IPE, which = r / IPM, q = r - which * IPM;
        if (which < 2) { const int kb = q / 112, nb = q - kb * 112; const float* W = (which ? I.m_w_up : I.m_w_gate) + (size_t)le * D * ED;
            transpose_item(W, D, ED, (bf16*)(ws + M_GU) + (size_t)le * 2 * ED * D, kb, nb, gu_row(32 * nb, which), scr, lane); }
        else { const int kb = q >> 5, nb = q & 31; transpose_item(I.m_w_down + (size_t)le * ED * D, ED, D, (bf16*)(ws + M_DN) + (size_t)le * D * ED, kb, nb, 32 * nb, scr, lane); }
    }
    constexpr int I_WIN = 16 * 128, I_WOUT = 32 * 32, I_QKV = 16 * 48, I_WO = 16 * 32, I_PW = 4 * 8, I_FG = 16 * 88, I_FD = 44 * 32;
    constexpr int NSM = 2 * I_WIN + 2 * I_WOUT + I_QKV + I_WO + 4 * I_PW + 4 * I_FG + 2 * I_FD;
    for (int it = gw; it < NSM; it += NGW) {
        int r = it;
        if (r < 2 * I_WIN) { const int j = r / I_WIN, q = r % I_WIN; transpose_item(I.a_w_in + (size_t)j * D * 4096, D, 4096, (bf16*)(ws + W_IN) + (size_t)j * 4096 * D, q / 128, q % 128, 32 * (q % 128), scr, lane); continue; } r -= 2 * I_WIN;
        if (r < 2 * I_WOUT) { const int j = r / I_WOUT, q = r % I_WOUT; transpose_item(I.a_w_out + (size_t)j * ADIM * D, ADIM, D, (bf16*)(ws + W_OUT) + (size_t)j * D * ADIM, q / 32, q % 32, 32 * (q % 32), scr, lane); continue; } r -= 2 * I_WOUT;
        if (r < I_QKV) { transpose_item(I.b_w_qkv, D, QKVW, (bf16*)(ws + W_QKV), r / 48, r % 48, qkv_row(32 * (r % 48)), scr, lane); continue; } r -= I_QKV;
        if (r < I_WO) { transpose_item(I.b_w_o, D, D, (bf16*)(ws + W_O), r / 32, r % 32, 32 * (r % 32), scr, lane); continue; } r -= I_WO;
        if (r < 4 * I_PW) { const int j = r / I_PW, q = r % I_PW; transpose_item(I.p_w + (size_t)j * 65536, 256, 256, (bf16*)(ws + W_P) + (size_t)j * 65536, q / 8, q % 8, 32 * (q % 8), scr, lane); continue; } r -= 4 * I_PW;
        if (r < 4 * I_FG) { const int f = r / (2 * I_FG), which = (r / I_FG) & 1, q = r % I_FG; const float* W = (which ? I.f_w_up : I.f_w_gate) + (size_t)f * D * FF;
            transpose_item(W, D, FF, (bf16*)(ws + W_GU) + (size_t)f * 2 * FF * D, q / 88, q % 88, gu_row(32 * (q % 88), which), scr, lane); continue; } r -= 4 * I_FG;
        { const int f = r / I_FD, q = r % I_FD; transpose_item(I.f_w_down + (size_t)f * FF * D, FF, D, (bf16*)(ws + W_DN) + (size_t)f * D * FF, q / 32, q % 32, 32 * (q % 32), scr, lane); }
    }
}
__device__ __forceinline__ void p0_adaln(const float* cvec, const float* cctx, const float* ada_w, unsigned char* ws, int lane, int wave, int G) {
    const int gw = (int)blockIdx.x * NWAVES + wave, NGW = G * NWAVES;
    for (int it = gw; it < 4 * 24 * 8; it += NGW) {
        const int i = it / 192, r = it % 192, cb = r >> 3, kc = r & 7;
        float sv[5][2];
#pragma unroll
        for (int b = 0; b < 5; ++b)
#pragma unroll
            for (int h = 0; h < 2; ++h) { const float xv = (b < 4 ? cvec + b * D : cctx)[kc * 128 + h * 64 + lane]; sv[b][h] = xv * pg8::sigmoidf_(xv); }
        const float* Wp = ada_w + (size_t)i * D * 6144 + (size_t)(kc * 128) * 6144 + cb * 256 + lane * 4;
        f32x4 a[5];
#pragma unroll
        for (int b = 0; b < 5; ++b) a[b] = (f32x4){0.f, 0.f, 0.f, 0.f};
#pragma unroll
        for (int h = 0; h < 2; ++h) {
#pragma unroll 8
            for (int kk = 0; kk < 64; ++kk) { const f32x4 w = *(const f32x4*)(Wp + (size_t)(h * 64 + kk) * 6144);
#pragma unroll
                for (int b = 0; b < 5; ++b) { const float s = __shfl(sv[b][h], kk); a[b] = a[b] + w * s; } }
        }
        const int col = cb * 256 + lane * 4;
#pragma unroll
        for (int b = 0; b < 5; ++b) *(f32x4*)((float*)(ws + WS_MODP) + ((size_t)(kc * 4 + i) * 5 + b) * 6144 + col) = a[b];
    }
    for (int it = gw; it < 16; it += NGW) {
        const int idx = it * 64 + lane, p = idx >> 4, f = idx & 15;
        const float inv = f == 0 ? 1.000000000e+00f : f == 1 ? 5.623413324e-01f : f == 2 ? 3.162277639e-01f : f == 3 ? 1.778279394e-01f : f == 4 ? 1.000000015e-01f : f == 5 ? 5.623413250e-02f
                        : f == 6 ? 3.162277490e-02f : f == 7 ? 1.778279431e-02f : f == 8 ? 9.999999776e-03f : f == 9 ? 5.623413250e-03f : f == 10 ? 3.162277630e-03f : f == 11 ? 1.778279431e-03f
                        : f == 12 ? 1.000000047e-03f : f == 13 ? 5.623413017e-04f : f == 14 ? 3.162277571e-04f : 1.778279402e-04f;
        const float angf = (float)p * inv; const double xd = (double)angf;
        const double kq = __builtin_rint(xd * 0.63661977236758134308); double rr = __builtin_fma(-kq, 1.57079632679489655800e+00, xd); rr = __builtin_fma(-kq, 6.12323399573676603587e-17, rr);
        const double r2 = rr * rr;
        double sp = -7.6471637318198164759e-13; sp = sp * r2 + 1.6059043836821614599e-10; sp = sp * r2 - 2.5052108385441718775e-08; sp = sp * r2 + 2.7557319223985890653e-06; sp = sp * r2 - 1.9841269841269841270e-04;
        sp = sp * r2 + 8.3333333333333333333e-03; sp = sp * r2 - 1.6666666666666666667e-01; const double sn = rr + rr * r2 * sp;
        double cp = 4.7794773323873852974e-14; cp = cp * r2 - 1.1470745597729724714e-11; cp = cp * r2 + 2.0876756987868098979e-09; cp = cp * r2 - 2.7557319223985890653e-07; cp = cp * r2 + 2.4801587301587301587e-05;
        cp = cp * r2 - 1.3888888888888888889e-03; cp = cp * r2 + 4.1666666666666666667e-02; cp = cp * r2 - 0.5; const double cs = 1.0 + r2 * cp;
        const int qd = (int)kq & 3; const double sv_ = qd == 0 ? sn : qd == 1 ? cs : qd == 2 ? -sn : -cs, cv_ = qd == 0 ? cs : qd == 1 ? -sn : qd == 2 ? -cs : sn;
        ((float*)(ws + WS_TAB))[idx] = (float)cv_; ((float*)(ws + WS_TAB + 4096))[idx] = (float)sv_;
    }
}


template <int MODE>
__device__ __forceinline__ void norm_phase(LAS unsigned char* lds, int tid, int lane, int wave, int G, int nrows,
        const float* srcL, const float* srcC, float* xs_out, const float* ng, const float* modsL, int w, bf16* H,
        const bf16* Y, const int* prow, const float* gprev,
        const float* router, unsigned* cnt, int* tok_e, int* tok_s, float* tok_g) {
    const int rpb = (nrows + G - 1) / G, r0 = (int)blockIdx.x * rpb, r1 = (r0 + rpb < nrows) ? r0 + rpb : nrows;
    LAS float* RT = (LAS float*)lds;
    LAS int* LE = (LAS int*)(lds + 32768); LAS float* LG = (LAS float*)(lds + 32768 + 4096); LAS int* LS = (LAS int*)(lds + 32768 + 8192); LAS int* LBASE = (LAS int*)(lds + 32768 + 12288);
    if (MODE == 1) { for (int i = tid; i < 2048; i += NWAVES * 64) ((LAS f32x4*)RT)[i] = ((const f32x4*)router)[i]; __syncthreads(); }
    int cur_b = -1; f32x4 gsv[4], shv[4], gpv[4];
    for (int r = r0 + wave; r < r1; r += NWAVES) {
        const int bidx = r < TL ? (r >> 12) : 4;
        if (bidx != cur_b) { cur_b = bidx;
#pragma unroll
            for (int j = 0; j < 4; ++j) { const int col = 4 * lane + 256 * j; const f32x4 g = *(const f32x4*)(ng + col), sc = *(const f32x4*)(modsL + bidx * 6144 + (3 * w + 1) * 1024 + col);
                gsv[j] = g * (sc + 1.f); shv[j] = *(const f32x4*)(modsL + bidx * 6144 + (3 * w) * 1024 + col);
                if (MODE == 2) gpv[j] = *(const f32x4*)(gprev + bidx * 6144 + col); } }
        const float* xr = (r < TL) ? srcL + (size_t)r * D : srcC + (size_t)(r - TL) * D;
        f32x4 v[4];
#pragma unroll
        for (int j = 0; j < 4; ++j) v[j] = *(const f32x4*)(xr + 4 * lane + 256 * j);
        if (MODE == 2) { const int p1 = prow[2 * r], p2 = prow[2 * r + 1];
#pragma unroll
            for (int j = 0; j < 4; ++j) { const u32x2 a = *(const u32x2*)(Y + (size_t)p1 * D + 4 * lane + 256 * j), b = *(const u32x2*)(Y + (size_t)p2 * D + 4 * lane + 256 * j);
                const f32x4 ys = (f32x4){bf_lo(a.x) + bf_lo(b.x), bf_hi(a.x) + bf_hi(b.x), bf_lo(a.y) + bf_lo(b.y), bf_hi(a.y) + bf_hi(b.y)};
                v[j] = v[j] + gpv[j] * ys; *(f32x4*)(xs_out + (size_t)r * D + 4 * lane + 256 * j) = v[j]; } }
        float ss = 0.f;
#pragma unroll
        for (int j = 0; j < 4; ++j) ss += (v[j].x * v[j].x + v[j].y * v[j].y) + (v[j].z * v[j].z + v[j].w * v[j].w);
        const float rstd = 1.0f / sqrtf(wave_sum(ss) * (1.f / D) + EPS);
        f32x4 hv[4];
#pragma unroll
        for (int j = 0; j < 4; ++j) { hv[j] = v[j] * rstd * gsv[j] + shv[j];
            u32x2 o; o.x = cvt_pk_bf16(hv[j].x, hv[j].y); o.y = cvt_pk_bf16(hv[j].z, hv[j].w); *(u32x2*)(H + (size_t)r * D + 4 * lane + 256 * j) = o; }
        if (MODE == 1) {
            float lg[8];
#pragma unroll
            for (int e = 0; e < 8; ++e) lg[e] = 0.f;
#pragma unroll
            for (int j = 0; j < 4; ++j)
#pragma unroll
                for (int i = 0; i < 4; ++i) { const LAS f32x4* rp = (const LAS f32x4*)(RT + (4 * lane + 256 * j + i) * 8); const f32x4 ra = rp[0], rb = rp[1]; const float hx = hv[j][i];
                    lg[0] += hx * ra.x; lg[1] += hx * ra.y; lg[2] += hx * ra.z; lg[3] += hx * ra.w; lg[4] += hx * rb.x; lg[5] += hx * rb.y; lg[6] += hx * rb.z; lg[7] += hx * rb.w; }
#pragma unroll
            for (int e = 0; e < 8; ++e) lg[e] = wave_sum(lg[e]);
            float b1 = lg[0]; int i1 = 0;
#pragma unroll
            for (int e = 1; e < 8; ++e) if (lg[e] > b1) { b1 = lg[e]; i1 = e; }
            float b2 = -INFINITY; int i2 = 0;
#pragma unroll
            for (int e = 0; e < 8; ++e) if (e != i1 && lg[e] > b2) { b2 = lg[e]; i2 = e; }
            const float ex = __expf(b2 - b1), g1 = 1.f / (1.f + ex), g2 = ex * g1;
            if (lane == 0) { const int li = 2 * (r - r0); LE[li] = i1; LE[li + 1] = i2; LG[li] = g1; LG[li + 1] = g2; }
        }
    }
    if (MODE == 1) {
        __syncthreads();
        const int n2 = 2 * (r1 - r0 > 0 ? r1 - r0 : 0);
        if (tid < 8) { int n = 0; for (int i = 0; i < n2; ++i) if (LE[i] == tid) { LS[i] = n; ++n; }
            LBASE[tid] = (int)__hip_atomic_fetch_add(cnt + tid, (unsigned)n, __ATOMIC_RELAXED, __HIP_MEMORY_SCOPE_AGENT); }
        __syncthreads();
        for (int i = tid; i < n2; i += NWAVES * 64) { const int e = LE[i]; tok_e[2 * r0 + i] = e; tok_s[2 * r0 + i] = LBASE[e] + LS[i]; tok_g[2 * r0 + i] = LG[i]; }
        __syncthreads();
    }
}

struct MoeLayout { int tp[9]; };
__device__ __forceinline__ MoeLayout moe_layout(const unsigned* cnt) {
    MoeLayout L; L.tp[0] = 0;
#pragma unroll
    for (int e = 0; e < 8; ++e) { const unsigned c = __hip_atomic_load(cnt + e, __ATOMIC_RELAXED, __HIP_MEMORY_SCOPE_AGENT); L.tp[e + 1] = L.tp[e] + (int)((c + 255u) >> 8); }
    return L;
}
__device__ __forceinline__ void permute_phase(int lane, int wave, int G, const unsigned* cnt, const int* tok_e, const int* tok_s, const float* tok_g, const bf16* H, bf16* AS, float* gwv, int* prow) {
    const MoeLayout L = moe_layout(cnt);
    const int gw = (int)blockIdx.x * NWAVES + wave, NGW = G * NWAVES;
    for (int t = gw; t < TL; t += NGW) {
        const u32x4 a = *(const u32x4*)(H + (size_t)t * D + lane * 8), b = *(const u32x4*)(H + (size_t)t * D + 512 + lane * 8);
#pragma unroll
        for (int j = 0; j < 2; ++j) { const int e = tok_e[2 * t + j], s = tok_s[2 * t + j]; int base = 0;
#pragma unroll
            for (int k = 1; k < 8; ++k) base = (e == k) ? L.tp[k] : base;
            const int row = base * 256 + s;
            *(u32x4*)(AS + (size_t)row * D + lane * 8) = a; *(u32x4*)(AS + (size_t)row * D + 512 + lane * 8) = b;
            if (lane == 0) { gwv[row] = tok_g[2 * t + j]; prow[2 * t + j] = row; } }
    }
}
__device__ __forceinline__ void final_phase(int lane, int wave, int G, const float* XS, const bf16* Y, const int* prow, const float* gprev, float* out) {
    const int gw = (int)blockIdx.x * NWAVES + wave, NGW = G * NWAVES;
    for (int r = gw; r < TL; r += NGW) { const int bidx = r >> 12; const int p1 = prow[2 * r], p2 = prow[2 * r + 1];
#pragma unroll
        for (int j = 0; j < 4; ++j) { const int col = 4 * lane + 256 * j; const u32x2 a = *(const u32x2*)(Y + (size_t)p1 * D + col), b = *(const u32x2*)(Y + (size_t)p2 * D + col);
            const f32x4 ys = (f32x4){bf_lo(a.x) + bf_lo(b.x), bf_hi(a.x) + bf_hi(b.x), bf_lo(a.y) + bf_lo(b.y), bf_hi(a.y) + bf_hi(b.y)};
            *(f32x4*)(out + (size_t)r * D + col) = *(const f32x4*)(XS + (size_t)r * D + col) + *(const f32x4*)(gprev + bidx * 6144 + col) * ys; } }
}
__device__ __forceinline__ void copy_phase(int lane, int wave, int G, const float* XS, float* out) {
    const int gw = (int)blockIdx.x * NWAVES + wave, NGW = G * NWAVES;
    for (int r = gw; r < TL; r += NGW)
#pragma unroll
        for (int j = 0; j < 4; ++j) { const int col = 4 * lane + 256 * j; *(f32x4*)(out + (size_t)r * D + col) = *(const f32x4*)(XS + (size_t)r * D + col); }
}

typedef short v4i16_t __attribute__((ext_vector_type(4)));
__device__ __forceinline__ void sgu_phase(LAS unsigned char* lds, int tid, int nchunks, const bf16* Z, const float* rowss, const float* wsp, const float* bsp, const float* vg, bf16* GT) {
    const int lane = tid & 63, wave = __builtin_amdgcn_readfirstlane(tid >> 6), fr = lane & 15, fq = lane >> 4;
    LAS float* RS = (LAS float*)lds; LAS unsigned char* WL = lds + 1024; LAS unsigned char* VL = lds + 1024 + 128 * 272;
    const int nunits = nchunks * 8;
    for (int un = (int)blockIdx.x; un < nunits; un += (int)gridDim.x) {
        const int ch = un >> 3, g = un & 7, rbase = ch * 128;
        if (tid < 128) { const f32x4* rp = (const f32x4*)(rowss + (size_t)(rbase + tid) * 32); float ssum = 0.f;
#pragma unroll
            for (int q = 0; q < 8; ++q) { const f32x4 pv = rp[q]; ssum += (pv.x + pv.y) + (pv.z + pv.w); }
            RS[tid] = 1.0f / sqrtf(ssum * (1.f / ADIM) + EPS); }
        __syncthreads();
#pragma unroll
        for (int k = 0; k < 8; ++k) { const int idx = tid + 512 * k, t = idx >> 5, s = (idx & 31) * 4;
            const f32x4 wv = *(const f32x4*)(wsp + (size_t)g * 16384 + t * 128 + s) * *(const LAS f32x4*)(RS + s);
            u32x2 o; o.x = cvt_pk_bf16(wv.x, wv.y); o.y = cvt_pk_bf16(wv.z, wv.w); *(LAS u32x2*)(WL + t * 272 + s * 2) = o; }
#pragma unroll
        for (int k = 0; k < 8; ++k) { const int idx = tid + 512 * k, sr = idx >> 5, c = idx & 31;
            *(LAS u32x4*)(VL + sr * 528 + c * 16) = *(const u32x4*)(Z + (size_t)(rbase + sr) * 4096 + ADIM + g * 256 + c * 8); }
        __syncthreads();
        f32x4 acc[2][8];
#pragma unroll
        for (int mb = 0; mb < 2; ++mb)
#pragma unroll
            for (int nb = 0; nb < 8; ++nb) acc[mb][nb] = (f32x4){0.f, 0.f, 0.f, 0.f};
#pragma unroll
        for (int ks = 0; ks < 4; ++ks) {
            bf16x8 a[2];
#pragma unroll
            for (int mb = 0; mb < 2; ++mb) { LAS unsigned char* p = VL + (32 * ks + 8 * fq + (fr >> 2)) * 528 + (32 * wave + 16 * mb + 4 * (fr & 3)) * 2;
                const v4i16_t lo = __builtin_amdgcn_ds_read_tr16_b64_v4i16((LAS v4i16_t*)p), hi = __builtin_amdgcn_ds_read_tr16_b64_v4i16((LAS v4i16_t*)(p + 4 * 528));
                a[mb] = (bf16x8){lo[0], lo[1], lo[2], lo[3], hi[0], hi[1], hi[2], hi[3]}; }
#pragma unroll
            for (int nb = 0; nb < 8; ++nb) { const bf16x8 b = *(const LAS bf16x8*)(WL + (16 * nb + fr) * 272 + (32 * ks + 8 * fq) * 2);
#pragma unroll
                for (int mb = 0; mb < 2; ++mb) acc[mb][nb] = __builtin_amdgcn_mfma_f32_16x16x32_bf16(a[mb], b, acc[mb][nb], 0, 0, 0); }
        }
#pragma unroll
        for (int mb = 0; mb < 2; ++mb) { const int dcol = g * 256 + 32 * wave + 16 * mb + 4 * fq; const f32x4 vgv = *(const f32x4*)(vg + dcol);
#pragma unroll
            for (int nb = 0; nb < 8; ++nb) { const int t = 16 * nb + fr; const size_t row = (size_t)(rbase + t); const float bsv = bsp[g * 128 + t];
                const u32x2 uu = *(const u32x2*)(Z + row * 4096 + dcol); const f32x4 mx = acc[mb][nb] * vgv + bsv;
                u32x2 o; o.x = cvt_pk_bf16(bf_lo(uu.x) * mx.x, bf_hi(uu.x) * mx.y); o.y = cvt_pk_bf16(bf_lo(uu.y) * mx.z, bf_hi(uu.y) * mx.w);
                *(u32x2*)(GT + row * ADIM + dcol) = o; } }
        __syncthreads();
    }
}

__device__ __forceinline__ void pool_phase(int tid, int G, const bf16* H, bf16* PB) {
    const int chunk = tid & 127, rs = tid >> 7, c0 = chunk * 8, half = 1 << (c0 >> 8);
    for (int un = (int)blockIdx.x; un < TL / 32; un += G) {
        for (int rr = 0; rr < 8; ++rr) { const int row = un * 32 + rs * 8 + rr, tb = row & (SEQ - 1), bb = row - tb;
            const int lo = tb - half > 0 ? tb - half : 0, hi = tb + half - 1 < SEQ - 1 ? tb + half - 1 : SEQ - 1;
            float s[8];
#pragma unroll
            for (int i = 0; i < 8; ++i) s[i] = 0.f;
            for (int q = lo; q <= hi; ++q) { const u32x4 v = *(const u32x4*)(H + (size_t)(bb + q) * D + c0);
                s[0] += bf_lo(v.x); s[1] += bf_hi(v.x); s[2] += bf_lo(v.y); s[3] += bf_hi(v.y); s[4] += bf_lo(v.z); s[5] += bf_hi(v.z); s[6] += bf_lo(v.w); s[7] += bf_hi(v.w); }
            const u32x4 o = *(const u32x4*)(H + (size_t)row * D + c0); const float inv = 1.f / (float)(hi - lo + 1);
            u32x4 w; w.x = cvt_pk_bf16(s[0] * inv - bf_lo(o.x), s[1] * inv - bf_hi(o.x)); w.y = cvt_pk_bf16(s[2] * inv - bf_lo(o.y), s[3] * inv - bf_hi(o.y));
            w.z = cvt_pk_bf16(s[4] * inv - bf_lo(o.z), s[5] * inv - bf_hi(o.z)); w.w = cvt_pk_bf16(s[6] * inv - bf_lo(o.w), s[7] * inv - bf_hi(o.w));
            *(u32x4*)(PB + (size_t)row * D + c0) = w; }
    }
}

struct Args { const float* in[25]; float* out; unsigned char* ws; int ph_lo, ph_hi; };
#define CAS __attribute__((address_space(4)))
__device__ __forceinline__ const CAS char* karg_base() { const CAS char* p = (const CAS char*)__builtin_amdgcn_kernarg_segment_ptr(); asm volatile("" : "+s"(p)); return p; }
__device__ __forceinline__ const float* karg_in(int k) { return *(const float* const CAS*)(karg_base() + 8 * k); }
__device__ __forceinline__ float* karg_out() { return *(float* const CAS*)(karg_base() + 200); }
__device__ __forceinline__ unsigned char* karg_ws() { return *(unsigned char* const CAS*)(karg_base() + 208); }
#define WSB(T, off) ((T*)(karg_ws() + (off)))
#define MODS(layer, which) (WSB(float, WS_MODS) + (layer) * 5 * 6144 + (which) * 1024)
#define XS_ WSB(float, WS_XS)
#define H_ WSB(bf16, WS_H)
#define CNT(l) ((unsigned*)(WSB(unsigned, WS_CTL) + CW_CNT + 64 * (l)))
#define NORM_G(i, w) (karg_in(6) + ((i) * 2 + (w)) * 1024)
__global__ void __launch_bounds__(NWAVES * 64, 2) trunk_fwd(Args args) {
    extern __shared__ __attribute__((aligned(16))) unsigned char lds_raw[];
    LAS unsigned char* const lds = (LAS unsigned char*)lds_raw;
    volatile LAS unsigned* const MISC = (volatile LAS unsigned*)(lds + MISC_OFF);
    const int wave = __builtin_amdgcn_readfirstlane((int)threadIdx.x >> 6), G = gridDim.x, bx = blockIdx.x;
#define lane ((int)__builtin_amdgcn_mbcnt_hi(~0u, __builtin_amdgcn_mbcnt_lo(~0u, 0u)))
#define tid (wave * 64 + lane)
    const int vcu = (G % 8 == 0) ? (bx % 8) * (G / 8) + bx / 8 : bx;
    static_assert(offsetof(Args, out) == 200 && offsetof(Args, ws) == 208, "kernarg layout");

    for (int u = (int)threadIdx.x; u < (LDS_BYTES - LDSCTL_OFF) / 4; u += NWAVES * 64) ((LAS unsigned*)(lds + LDSCTL_OFF))[u] = 0u;
    __syncthreads();
    XcdBarrier bar; bar.bar = WSB(unsigned, WS_CTL) + CW_BAR; bar.x = 0; bar.st = nullptr;
    if (!MK_PER_PHASE) bar = xcd_barrier_post(WSB(unsigned, WS_CTL) + CW_BAR, MISC + 8, tid);
#define GRID_BAR() do { if (MK_PER_PHASE) { if (tid == 0) __hip_atomic_store((gu32*)WSB(unsigned, WS_CTL) + CW_TMO, 0xBADBA0u, RLX_AGENT); } else { xcd_barrier(bar, tid); } } while (0)
    const int lo = args.ph_lo, hi = args.ph_hi;
#define IN(k) (lo <= (k) && (k) < hi && (k) <= DBG_STOP)
#define SEAM(k) do { if (IN(k) && IN((k) + 1)) GRID_BAR(); } while (0)
#define GEMM_PHASE(EPI, ORD, nM, nN, gm, ep) do { pg8::ORD S_; S_.init((nM), (nN), G, bx); pg8::gemm_phase<pg8::EPI, pg8::ORD, true>(lds + RING_OFF, tid, gm, S_, ep); } while (0)
#define MOE_PHASE(EPI, l, nN, gm, ep) do { const MoeLayout L_ = moe_layout(CNT(l)); pg8::MoeOrder S_; S_.init(L_.tp[8], (nN), G, bx); _Pragma("unroll") for (int k_ = 0; k_ < 8; ++k_) S_.tp[k_] = L_.tp[k_]; \
        pg8::gemm_phase<pg8::EPI, pg8::MoeOrder, true>(lds + RING_OFF, tid, gm, S_, ep); } while (0)
#define NORM0(nrows, srcL, srcC, layer, w) norm_phase<0>(lds, tid, lane, wave, G, nrows, srcL, srcC, nullptr, NORM_G(layer, w), MODS(layer, 0), w, H_, nullptr, nullptr, nullptr, nullptr, nullptr, nullptr, nullptr, nullptr)

    if (IN(0)) { p0_adaln(karg_in(1), karg_in(3), karg_in(4), karg_ws(), lane, wave, G); } SEAM(0);
    if (IN(1)) { In I; I.x = karg_in(0); I.c = karg_in(1); I.ctx = karg_in(2); I.c_ctx = karg_in(3); I.ada_w = karg_in(4); I.ada_b = karg_in(5); I.norm_g = karg_in(6); I.a_w_in = karg_in(7); I.a_v_g = karg_in(8);
        I.a_ws = karg_in(9); I.a_bs = karg_in(10); I.a_w_out = karg_in(11); I.b_w_qkv = karg_in(12); I.b_q_g = karg_in(13); I.b_k_g = karg_in(14); I.b_w_o = karg_in(15); I.p_w = karg_in(16); I.p_scale = karg_in(17);
        I.f_w_gate = karg_in(18); I.f_w_up = karg_in(19); I.f_w_down = karg_in(20); I.m_router = karg_in(21); I.m_w_gate = karg_in(22); I.m_w_up = karg_in(23); I.m_w_down = karg_in(24);
        p1_convert(I, karg_ws(), lds, lane, wave, G); } SEAM(1);
    if (IN(2)) { NORM0(TT, karg_in(0), karg_in(2), 0, 0); } SEAM(2);
    if (IN(3)) { pg8::Gemm g{H_, WSB(const bf16, W_IN), D, D, 0, 0}; pg8::EpiGelu E{WSB(bf16, WS_BIG), WSB(float, WS_RSP)}; GEMM_PHASE(EpiGelu, StaticOrder, TT / 256, 16, g, E); } SEAM(3);
    if (IN(4)) { sgu_phase(lds, tid, TT / 128, WSB(const bf16, WS_BIG), WSB(const float, WS_RSP), karg_in(9), karg_in(10), karg_in(8), WSB(bf16, WS_R2)); } SEAM(4);
    if (IN(5)) { pg8::Gemm g{WSB(const bf16, WS_R2), WSB(const bf16, W_OUT), ADIM, ADIM, 0, 0}; pg8::EpiResid E{karg_in(0), karg_in(2), XS_, MODS(0, 2), nullptr}; GEMM_PHASE(EpiResid, StaticOrder, TT / 256, 4, g, E); } SEAM(5);
    if (IN(6)) { NORM0(TT, XS_, XS_ + (size_t)TL * D, 0, 1); } SEAM(6);
    if (IN(7)) { pg8::Gemm g{H_, WSB(const bf16, W_GU), D, D, 0, 0}; pg8::EpiSwiGLU E{WSB(bf16, WS_BIG), FF}; GEMM_PHASE(EpiSwiGLU, StaticOrder, TT / 256, 2 * FF / 256, g, E); } SEAM(7);
    if (IN(8)) { pg8::Gemm g{WSB(const bf16, WS_BIG), WSB(const bf16, W_DN), FF, FF, 0, 0}; float* xs = XS_; pg8::EpiResid E{xs, xs + (size_t)TL * D, xs, MODS(0, 5), nullptr}; GEMM_PHASE(EpiResid, StaticOrder, TT / 256, 4, g, E); } SEAM(8);
    if (IN(9)) { NORM0(TT, XS_, XS_ + (size_t)TL * D, 1, 0); } SEAM(9);
    if (IN(10)) { pg8::Gemm g{H_, WSB(const bf16, W_QKV), D, D, 0, 0};
        pg8::EpiQKV E{WSB(bf16, WS_BIG), WSB(bf16, WS_BIG + 64 * MiB), WSB(bf16, WS_BIG + 73 * MiB), karg_in(13), karg_in(14), WSB(const float, WS_TAB), WSB(const float, WS_TAB + 4096), attn_body::C2};
        GEMM_PHASE(EpiQKV, StaticOrder, TT / 256, QKVW / 256, g, E); } SEAM(10);
    if (IN(11)) { const attn_body::AttnTensors AT{WSB(const attn_body::bf16, WS_BIG), WSB(const attn_body::bf16, WS_BIG + 64 * MiB), WSB(const attn_body::bf16, WS_BIG + 73 * MiB), WSB(attn_body::bf16, WS_BIG + 32 * MiB)};
        const attn_body::StaticOrder S(G, vcu); attn_body::attn_phase<attn_body::StaticOrder>(tid, (char*)lds_raw + RING_OFF, AT, S); } SEAM(11);
    if (IN(12)) { pg8::Gemm g{WSB(const bf16, WS_BIG + 32 * MiB), WSB(const bf16, W_O), D, D, 0, 0}; float* xs = XS_; pg8::EpiResid E{xs, xs + (size_t)TL * D, xs, MODS(1, 2), nullptr}; GEMM_PHASE(EpiResid, StaticOrder, TL / 256, 4, g, E); } SEAM(12);
    if (IN(13)) { norm_phase<1>(lds, tid, lane, wave, G, TL, XS_, XS_ + (size_t)TL * D, nullptr, NORM_G(1, 1), MODS(1, 0), 1, H_, nullptr, nullptr, nullptr, karg_in(21), CNT(0), WSB(int, WS_TOKE), WSB(int, WS_TOKS), WSB(float, WS_TOKG)); } SEAM(13);
    if (IN(14)) { permute_phase(lane, wave, G, CNT(0), WSB(const int, WS_TOKE), WSB(const int, WS_TOKS), WSB(const float, WS_TOKG), H_, WSB(bf16, WS_R2), WSB(float, WS_GW), WSB(int, WS_PROW)); } SEAM(14);
    if (IN(15)) { pg8::Gemm g{WSB(const bf16, WS_R2), WSB(const bf16, M_GU), D, D, 0, (size_t)2 * ED * D}; pg8::EpiSwiGLU E{WSB(bf16, WS_BIG), ED}; MOE_PHASE(EpiSwiGLU, 0, 2 * ED / 256, g, E); } SEAM(15);
    if (IN(16)) { pg8::Gemm g{WSB(const bf16, WS_BIG), WSB(const bf16, M_DN), ED, ED, 0, (size_t)D * ED}; pg8::EpiMoeDown E{WSB(bf16, WS_R2), WSB(const float, WS_GW)}; MOE_PHASE(EpiMoeDown, 0, 4, g, E); } SEAM(16);
    if (IN(17)) { float* xs = XS_; norm_phase<2>(lds, tid, lane, wave, G, TL, xs, xs + (size_t)TL * D, xs, NORM_G(2, 0), MODS(2, 0), 0, H_, WSB(const bf16, WS_R2), WSB(const int, WS_PROW), MODS(1, 5), nullptr, nullptr, nullptr, nullptr, nullptr); } SEAM(17);
    if (IN(18)) { pool_phase(tid, G, H_, WSB(bf16, WS_BIG)); } SEAM(18);
    if (IN(19)) { pg8::Gemm g{WSB(const bf16, WS_BIG), WSB(const bf16, W_P), 256, D, 256, 0}; float* xs = XS_; pg8::EpiResid E{xs, xs + (size_t)TL * D, xs, MODS(2, 2), karg_in(17)}; GEMM_PHASE(EpiResid, StaticOrder, TL / 256, 4, g, E); } SEAM(19);
    if (IN(20)) { NORM0(TL, XS_, XS_ + (size_t)TL * D, 2, 1); } SEAM(20);
    if (IN(21)) { pg8::Gemm g{H_, WSB(const bf16, W_GU) + (size_t)2 * FF * D, D, D, 0, 0}; pg8::EpiSwiGLU E{WSB(bf16, WS_BIG), FF}; GEMM_PHASE(EpiSwiGLU, StaticOrder, TL / 256, 2 * FF / 256, g, E); } SEAM(21);
    if (IN(22)) { pg8::Gemm g{WSB(const bf16, WS_BIG), WSB(const bf16, W_DN) + (size_t)D * FF, FF, FF, 0, 0}; float* xs = XS_; pg8::EpiResid E{xs, xs + (size_t)TL * D, xs, MODS(2, 5), nullptr}; GEMM_PHASE(EpiResid, StaticOrder, TL / 256, 4, g, E); } SEAM(22);
    if (IN(23)) { NORM0(TL, XS_, XS_ + (size_t)TL * D, 3, 0); } SEAM(23);
    if (IN(24)) { pg8::Gemm g{H_, WSB(const bf16, W_IN) + (size_t)4096 * D, D, D, 0, 0}; pg8::EpiGelu E{WSB(bf16, WS_BIG), WSB(float, WS_RSP)}; GEMM_PHASE(EpiGelu, StaticOrder, TL / 256, 16, g, E); } SEAM(24);
    if (IN(25)) { sgu_phase(lds, tid, TL / 128, WSB(const bf16, WS_BIG), WSB(const float, WS_RSP), karg_in(9) + 8 * 16384, karg_in(10) + 8 * 128, karg_in(8) + ADIM, WSB(bf16, WS_R2)); } SEAM(25);
    if (IN(26)) { pg8::Gemm g{WSB(const bf16, WS_R2), WSB(const bf16, W_OUT) + (size_t)D * ADIM, ADIM, ADIM, 0, 0}; float* xs = XS_; pg8::EpiResid E{xs, xs + (size_t)TL * D, xs, MODS(3, 2), nullptr}; GEMM_PHASE(EpiResid, StaticOrder, TL / 256, 4, g, E); } SEAM(26);
    if (IN(27)) { norm_phase<1>(lds, tid, lane, wave, G, TL, XS_, XS_ + (size_t)TL * D, nullptr, NORM_G(3, 1), MODS(3, 0), 1, H_, nullptr, nullptr, nullptr, karg_in(21) + 8192, CNT(1), WSB(int, WS_TOKE), WSB(int, WS_TOKS), WSB(float, WS_TOKG)); } SEAM(27);
    if (IN(28)) { permute_phase(lane, wave, G, CNT(1), WSB(const int, WS_TOKE), WSB(const int, WS_TOKS), WSB(const float, WS_TOKG), H_, WSB(bf16, WS_R2), WSB(float, WS_GW), WSB(int, WS_PROW)); } SEAM(28);
    if (IN(29)) { pg8::Gemm g{WSB(const bf16, WS_R2), WSB(const bf16, M_GU) + (size_t)8 * 2 * ED * D, D, D, 0, (size_t)2 * ED * D}; pg8::EpiSwiGLU E{WSB(bf16, WS_BIG), ED}; MOE_PHASE(EpiSwiGLU, 1, 2 * ED / 256, g, E); } SEAM(29);
    if (IN(30)) { pg8::Gemm g{WSB(const bf16, WS_BIG), WSB(const bf16, M_DN) + (size_t)8 * D * ED, ED, ED, 0, (size_t)D * ED}; pg8::EpiMoeDown E{WSB(bf16, WS_R2), WSB(const float, WS_GW)}; MOE_PHASE(EpiMoeDown, 1, 4, g, E); } SEAM(30);
    if (IN(31)) { final_phase(lane, wave, G, XS_, WSB(const bf16, WS_R2), WSB(const int, WS_PROW), MODS(3, 5), karg_out()); }
    if (DBG_STOP < 31 && (MK_PER_PHASE ? (lo == DBG_STOP + 1) : true)) {
        if (!MK_PER_PHASE) GRID_BAR();
        copy_phase(lane, wave, G, XS_, karg_out());
    }
#undef IN
#undef SEAM
#undef lane
#undef tid
}

extern "C" void kernel_launch(void* const* d_in, const int* in_sizes, int n_in, void* d_out, int out_size, void* d_ws, size_t ws_size, hipStream_t stream) {
    static int grid = 0;
    if (grid == 0) {
        if (n_in != 25 || out_size != TL * D || ws_size < WS_END) { fprintf(stderr, "kernel_launch: unexpected problem: n_in %d out %d ws %zu (need %zu)\n", n_in, out_size, ws_size, (size_t)WS_END); grid = -1; return; }
        int dev = 0, cus = 0, per_cu = 0;
        if (hipGetDevice(&dev) != hipSuccess || hipDeviceGetAttribute(&cus, hipDeviceAttributeMultiprocessorCount, dev) != hipSuccess) { grid = -1; return; }
        if (hipFuncSetAttribute((const void*)trunk_fwd, hipFuncAttributeMaxDynamicSharedMemorySize, LDS_BYTES) != hipSuccess) { fprintf(stderr, "kernel_launch: hipFuncSetAttribute failed\n"); grid = -1; return; }
        if (hipOccupancyMaxActiveBlocksPerMultiprocessor(&per_cu, (const void*)trunk_fwd, NWAVES * 64, LDS_BYTES) != hipSuccess || per_cu < 1) fprintf(stderr, "kernel_launch: occupancy query reports %d\n", per_cu);
        (void)hipGetLastError();
        grid = cus;
    }
    if (grid < 0) return;
    if (hipMemsetAsync((char*)d_ws + WS_CTL, 0, CTL_ZERO_BYTES, stream) != hipSuccess) return;
    Args a{};
    for (int i = 0; i < 25; ++i) a.in[i] = (const float*)d_in[i];
    a.out = (float*)d_out; a.ws = (unsigned char*)d_ws;
    if (MK_PER_PHASE) {
        for (int k = 0; k < NPH; ++k) { if (k > DBG_STOP + 1) break; a.ph_lo = k; a.ph_hi = k + 1; hipLaunchKernelGGL(trunk_fwd, dim3(grid), dim3(NWAVES * 64), LDS_BYTES, stream, a); }
    } else { a.ph_lo = 0; a.ph_hi = NPH; hipLaunchKernelGGL(trunk_fwd, dim3(grid), dim3(NWAVES * 64), LDS_BYTES, stream, a); }
}
```

```cpp
#include <hip/hip_runtime.h>
#include <hip/hip_bf16.h>
#include <cstdio>
#include <cstdint>
#include <cmath>

namespace pg8 {
#define PG8_LAS __attribute__((address_space(3)))
typedef unsigned short bf16_t;
typedef short bf16x8 __attribute__((ext_vector_type(8)));
typedef float f32x4 __attribute__((ext_vector_type(4)));
typedef float f32x2 __attribute__((ext_vector_type(2)));
typedef unsigned u32x4 __attribute__((ext_vector_type(4)));
typedef unsigned u32x2 __attribute__((ext_vector_type(2)));
constexpr int BM = 256, BK = 64, HALF = 128, HTB = HALF * BK * 2  , STAGE_BYTES = 8 * HTB, NXCD = 8, WGM = 8;

__host__ __device__ __forceinline__ int lds_byte(int r, int c) { const int st = (r >> 4) * 2 + (c >> 5), rr = r & 15, cc = c & 31, ob = rr * 64 + cc * 2; return st * 1024 + (ob ^ (((ob >> 9) & 1) << 5)); }
__host__ __device__ __forceinline__ void stage_rc(int b, int& R, int& C) { const int st = b / 1024, sb = b % 1024, swz = sb ^ (((sb >> 9) & 1) << 5); R = (st >> 1) * 16 + swz / 64; C = (st & 1) * 32 + (swz % 64) / 2; }
__host__ __device__ __forceinline__ int perm32(int rho) { const int n = rho >> 4, i = rho & 15; return 8 * (i >> 2) + 4 * n + (i & 3); }

struct Unit { int pm, pn, e; };
struct Gemm { const bf16_t* A; const bf16_t* Bt; int K; int lda; int a_pn_stride; size_t b_e_stride; };

struct StaticOrder {
    int nM, nN, nwg, G, c;
    __device__ void init(int nM_, int nN_, int G_, int c_) { nM = nM_; nN = nN_; nwg = nM * nN; G = G_; c = c_; }
    __device__ bool next(int i, Unit& u) const {
        const long L = (long)i * G + c; if (L >= nwg) return false;
        int wgid = (int)L; { const int q = nwg / NXCD, r = nwg % NXCD, xcd = wgid % NXCD, off = wgid / NXCD; wgid = (xcd < r ? xcd * (q + 1) : r * (q + 1) + (xcd - r) * q) + off; }
        const int nig = WGM * nN, gid = wgid / nig, fm = gid * WGM, gsz = (nM - fm) < WGM ? (nM - fm) : WGM;
        u.pm = fm + ((wgid % nig) % gsz); u.pn = (wgid % nig) / gsz; u.e = 0; return true;
    }
};
struct MoeOrder : StaticOrder {
    int tp[8];
    __device__ bool next(int i, Unit& u) const {
        if (!StaticOrder::next(i, u)) return false;
        int e = 0;
#pragma unroll
        for (int k = 1; k < 8; ++k) e += (u.pm >= tp[k]) ? 1 : 0;
        u.e = e; return true;
    }
};

__device__ __forceinline__ unsigned cvt_pk_bf16(float lo, float hi) { unsigned r; asm volatile("v_cvt_pk_bf16_f32 %0, %1, %2" : "=v"(r) : "v"(lo), "v"(hi)); return r; }
__device__ __forceinline__ float bf_lo(unsigned w) { return __builtin_bit_cast(float, w << 16); }
__device__ __forceinline__ float bf_hi(unsigned w) { return __builtin_bit_cast(float, w & 0xffff0000u); }
__device__ __forceinline__ float sigmoidf_(float x) { return __builtin_amdgcn_rcpf(1.f + __builtin_amdgcn_exp2f(-1.4426950408889634f * x)); }
__device__ __forceinline__ float gelu_tanh(float x) { const float y = 1.5957691216057308f * x * (1.f + 0.044715f * x * x); return x * sigmoidf_(y); }

typedef f32x4 AccT[2][2][4][2];

struct EpiGelu {
    static constexpr bool PERM = true;
    bf16_t* Z; float* rowss;
    __device__ __forceinline__ void operator()(const AccT& acc, const Unit& u, int wr, int wc, int fr, int fq) const {
        const int row0 = u.pm * BM + wr * 64 + fr, col0 = u.pn * BM + wc * 32 + 8 * fq; const bool isv = u.pn >= 8;
#pragma unroll
        for (int ai = 0; ai < 2; ++ai)
#pragma unroll
            for (int m = 0; m < 4; ++m) { const int row = row0 + ai * HALF + m * 16; bf16_t* rowp = Z + (size_t)row * 4096 + col0; float ss = 0.f;
#pragma unroll
                for (int bj = 0; bj < 2; ++bj) { f32x4 v0 = acc[ai][bj][m][0], v1 = acc[ai][bj][m][1];
#pragma unroll
                    for (int j = 0; j < 4; ++j) { v0[j] = gelu_tanh(v0[j]); v1[j] = gelu_tanh(v1[j]); ss += v0[j] * v0[j] + v1[j] * v1[j]; }
                    u32x4 w; w.x = cvt_pk_bf16(v0[0], v0[1]); w.y = cvt_pk_bf16(v0[2], v0[3]); w.z = cvt_pk_bf16(v1[0], v1[1]); w.w = cvt_pk_bf16(v1[2], v1[3]);
                    *(u32x4*)(rowp + bj * HALF) = w; }
                if (isv) { ss += __shfl_xor(ss, 16); ss += __shfl_xor(ss, 32); if (fq == 0) rowss[(size_t)row * 32 + (u.pn - 8) * 4 + wc] = ss; } }
    }
};
struct EpiResid {
    static constexpr bool PERM = false;
    const float* base_l; const float* base_c; float* out; const float* gate; const float* cscale;
    __device__ __forceinline__ void operator()(const AccT& acc, const Unit& u, int wr, int wc, int fr, int fq) const {
        const int row0 = u.pm * BM + wr * 64 + fr, col0 = u.pn * BM + wc * 32 + 4 * fq; const bool lat = u.pm < 64; const int bidx = lat ? (u.pm >> 4) : 4;
        f32x4 gv[2][2];
#pragma unroll
        for (int bj = 0; bj < 2; ++bj)
#pragma unroll
            for (int n = 0; n < 2; ++n) { gv[bj][n] = *(const f32x4*)(gate + bidx * 6144 + col0 + bj * HALF + n * 16); if (cscale) gv[bj][n] = gv[bj][n] * *(const f32x4*)(cscale + col0 + bj * HALF + n * 16); }
#pragma unroll
        for (int ai = 0; ai < 2; ++ai)
#pragma unroll
            for (int m = 0; m < 4; ++m) { const int row = row0 + ai * HALF + m * 16;
                const float* bp = (lat ? base_l + (size_t)row * 1024 : base_c + (size_t)(row - 16384) * 1024) + col0; float* op = out + (size_t)row * 1024 + col0;
#pragma unroll
                for (int bj = 0; bj < 2; ++bj)
#pragma unroll
                    for (int n = 0; n < 2; ++n) { const f32x4 o = *(const f32x4*)(bp + bj * HALF + n * 16) + gv[bj][n] * acc[ai][bj][m][n]; *(f32x4*)(op + bj * HALF + n * 16) = o; }
                if (m & 1) asm volatile("" ::: "memory"); }
    }
};
struct EpiSwiGLU {
    static constexpr bool PERM = true;
    bf16_t* Hd; int ldh;
    __device__ __forceinline__ void operator()(const AccT& acc, const Unit& u, int wr, int wc, int fr, int fq) const {
        const int row0 = u.pm * BM + wr * 64 + fr, col0 = u.pn * HALF + wc * 32 + 8 * fq;
#pragma unroll
        for (int ai = 0; ai < 2; ++ai)
#pragma unroll
            for (int m = 0; m < 4; ++m) { const int row = row0 + ai * HALF + m * 16; float o[8];
#pragma unroll
                for (int n = 0; n < 2; ++n)
#pragma unroll
                    for (int j = 0; j < 4; ++j) { const float gt = acc[ai][0][m][n][j], up = acc[ai][1][m][n][j]; o[4 * n + j] = gt * sigmoidf_(gt) * up; }
                u32x4 w; w.x = cvt_pk_bf16(o[0], o[1]); w.y = cvt_pk_bf16(o[2], o[3]); w.z = cvt_pk_bf16(o[4], o[5]); w.w = cvt_pk_bf16(o[6], o[7]);
                *(u32x4*)(Hd + (size_t)row * ldh + col0) = w; }
    }
};
struct EpiMoeDown {
    static constexpr bool PERM = true;
    bf16_t* Y; const float* gw;
    __device__ __forceinline__ void operator()(const AccT& acc, const Unit& u, int wr, int wc, int fr, int fq) const {
        const int row0 = u.pm * BM + wr * 64 + fr, col0 = u.pn * BM + wc * 32 + 8 * fq;
#pragma unroll
        for (int ai = 0; ai < 2; ++ai)
#pragma unroll
            for (int m = 0; m < 4; ++m) { const int row = row0 + ai * HALF + m * 16; const float s = gw[row]; bf16_t* rowp = Y + (size_t)row * 1024 + col0;
#pragma unroll
                for (int bj = 0; bj < 2; ++bj) { const f32x4 v0 = acc[ai][bj][m][0] * s, v1 = acc[ai][bj][m][1] * s;
                    u32x4 w; w.x = cvt_pk_bf16(v0[0], v0[1]); w.y = cvt_pk_bf16(v0[2], v0[3]); w.z = cvt_pk_bf16(v1[0], v1[1]); w.w = cvt_pk_bf16(v1[2], v1[3]);
                    *(u32x4*)(rowp + bj * HALF) = w; } }
    }
};
struct EpiQKV {
    static constexpr bool PERM = true;
    bf16_t* Q; bf16_t* Kb; bf16_t* Vb; const float* qg; const float* kg; const float* ctab; const float* stab; float c2;
    __device__ __forceinline__ void operator()(const AccT& acc, const Unit& u, int wr, int wc, int fr, int fq) const {
        const int row0 = u.pm * BM + wr * 64 + fr; const bool ctx = u.pm >= 64; const int pn = u.pn;
        if (ctx && pn < 4) return;
        const float* gsrc = pn < 4 ? qg : kg;
        f32x4 gq[2][2];
#pragma unroll
        for (int bj = 0; bj < 2; ++bj)
#pragma unroll
            for (int n = 0; n < 2; ++n) gq[bj][n] = *(const f32x4*)(gsrc + 32 * bj + 8 * fq + 4 * n);
        const int fo = 8 * (fq & 1); const bool hf = (fq >> 1) != 0;
#pragma unroll
        for (int ai = 0; ai < 2; ++ai)
#pragma unroll
            for (int m = 0; m < 4; ++m) { const int row = row0 + ai * HALF + m * 16;
                int kvrow; int t = 0;
                if (ctx) { const int rc = row - 16384; kvrow = (rc >> 8) * 4352 + (rc & 255); } else { t = row & 4095; kvrow = (row >> 12) * 4352 + 256 + t; }
                if (pn == 5) {
#pragma unroll
                    for (int bj = 0; bj < 2; ++bj) { const f32x4 v0 = acc[ai][bj][m][0], v1 = acc[ai][bj][m][1];
                        u32x4 w; w.x = cvt_pk_bf16(v0[0], v0[1]); w.y = cvt_pk_bf16(v0[2], v0[3]); w.z = cvt_pk_bf16(v1[0], v1[1]); w.w = cvt_pk_bf16(v1[2], v1[3]);
                        *(u32x4*)(Vb + (size_t)kvrow * 256 + wc * 64 + 32 * bj + 8 * fq) = w; }
                } else {
                    float ss = 0.f;
#pragma unroll
                    for (int bj = 0; bj < 2; ++bj)
#pragma unroll
                        for (int n = 0; n < 2; ++n)
#pragma unroll
                            for (int j = 0; j < 4; ++j) { const float a = acc[ai][bj][m][n][j]; ss += a * a; }
                    ss += __shfl_xor(ss, 16); ss += __shfl_xor(ss, 32);
                    const float rstd = __builtin_amdgcn_rsqf(ss * (1.f / 64.f) + 1e-6f);
#pragma unroll
                    for (int bj = 0; bj < 2; ++bj) { f32x4 v[2];
#pragma unroll
                        for (int n = 0; n < 2; ++n) v[n] = acc[ai][bj][m][n] * rstd * gq[bj][n];
                        if (!ctx) { const int p = bj == 0 ? (t >> 6) : (t & 63);
#pragma unroll
                            for (int n = 0; n < 2; ++n) { const f32x4 cc = *(const f32x4*)(ctab + p * 16 + fo + 4 * n), sn = *(const f32x4*)(stab + p * 16 + fo + 4 * n);
#pragma unroll
                                for (int j = 0; j < 4; ++j) { const float own = v[n][j], oth = __shfl_xor(own, 32);
                                    v[n][j] = hf ? (own * cc[j] + oth * sn[j]) : (own * cc[j] - oth * sn[j]); } } }
                        if (pn < 4) { v[0] = v[0] * c2; v[1] = v[1] * c2; }
                        u32x4 w; w.x = cvt_pk_bf16(v[0][0], v[0][1]); w.y = cvt_pk_bf16(v[0][2], v[0][3]); w.z = cvt_pk_bf16(v[1][0], v[1][1]); w.w = cvt_pk_bf16(v[1][2], v[1][3]);
                        if (pn < 4) *(u32x4*)(Q + (size_t)row * 1024 + (4 * pn + wc) * 64 + 32 * bj + 8 * fq) = w;
                        else        *(u32x4*)(Kb + (size_t)kvrow * 256 + wc * 64 + 32 * bj + 8 * fq) = w; }
                } }
    }
};

template <class Epi, class Sched, bool ALIGN_EPI = false>
__device__ __forceinline__ void gemm_phase(PG8_LAS unsigned char* lds, const int tid, const Gemm g, const Sched& S, const Epi& E) {
    const int wid = __builtin_amdgcn_readfirstlane(tid >> 6), lane = tid & 63, wr = wid >> 2, wc = wid & 3, fr = lane & 15, fq = lane >> 4;
    const int K = g.K, nt = K / BK;
    unsigned voffB[2]; int RA[2], CA[2];
#pragma unroll
    for (int i = 0; i < 2; ++i) { int R, C; stage_rc(tid * 16 + i * 8192, R, C); const int Rb = Epi::PERM ? ((R & ~31) + perm32(R & 31)) : R;
        RA[i] = R; CA[i] = C; voffB[i] = (unsigned)(Rb * K + C) * 2u; }
    const size_t kstep = (size_t)(BK * 2);
    const size_t hstep = (size_t)HALF * K * 2;
    const size_t tstep = 2 * hstep;
#define PG8_CALCA(u, v) do { _Pragma("unroll") for (int _h = 0; _h < 2; ++_h) _Pragma("unroll") for (int _i = 0; _i < 2; ++_i) \
        v[_h][_i] = (unsigned)(((u).pm * BM + _h * HALF + RA[_i]) * g.lda + (u).pn * g.a_pn_stride + CA[_i]) * 2u; } while (0)
    const unsigned ldsw = (unsigned)wid * 1024u;
    const int aoff = lds_byte(wr * 64 + fr, fq * 8), boff = lds_byte(wc * 32 + fr, fq * 8);
#define PG8_SA(b, h) (((b) * 2 + (h)) * HTB)
#define PG8_SB(b, h) ((4 + (b) * 2 + (h)) * HTB)
#define PG8_STAGE(bufoff, gbase, voff) do { _Pragma("unroll") for (int _i = 0; _i < 2; ++_i) \
        __builtin_amdgcn_global_load_lds((const unsigned*)((const char*)(gbase) + (voff)[_i]), (PG8_LAS unsigned*)(lds + (bufoff) + ldsw + _i * 8192), 16, 0, 0); } while (0)
#define PG8_LDA(dst, b, h) do { _Pragma("unroll") for (int m = 0; m < 4; ++m) _Pragma("unroll") for (int k = 0; k < 2; ++k) dst[m][k] = *(const PG8_LAS bf16x8*)(lds + PG8_SA(b, h) + aoff + m * 2048 + k * 1024); } while (0)
#define PG8_LDB(dst, b, h) do { _Pragma("unroll") for (int n = 0; n < 2; ++n) _Pragma("unroll") for (int k = 0; k < 2; ++k) dst[n][k] = *(const PG8_LAS bf16x8*)(lds + PG8_SB(b, h) + boff + n * 2048 + k * 1024); } while (0)
#define PG8_MMA(ai, bj, At, Bt) do { __builtin_amdgcn_s_setprio(1); _Pragma("unroll") for (int m = 0; m < 4; ++m) _Pragma("unroll") for (int n = 0; n < 2; ++n) _Pragma("unroll") for (int k = 0; k < 2; ++k) \
        acc[ai][bj][m][n] = __builtin_amdgcn_mfma_f32_16x16x32_bf16(Bt[n][k], At[m][k], acc[ai][bj][m][n], 0, 0, 0); __builtin_amdgcn_s_setprio(0); } while (0)
#define PG8_WAIT_V(n) asm volatile("s_waitcnt vmcnt(" #n ")" ::: "memory")
#define PG8_WAIT_L(n) asm volatile("s_waitcnt lgkmcnt(" #n ")" ::: "memory")
#define PG8_BAR __builtin_amdgcn_s_barrier()
#define PG8_SCHED __builtin_amdgcn_sched_barrier(0)
    Unit cur, nxt; int ui = 0;
    if (!S.next(0, cur)) return;
    f32x4 acc[2][2][4][2];
#pragma unroll
    for (int a = 0; a < 2; ++a)
#pragma unroll
        for (int b = 0; b < 2; ++b)
#pragma unroll
            for (int m = 0; m < 4; ++m)
#pragma unroll
                for (int n = 0; n < 2; ++n) acc[a][b][m][n] = (f32x4){0.f, 0.f, 0.f, 0.f};
    bf16x8 At[4][2], B0[2][2], B1[2][2];
    const char* const Ab = (const char*)g.A; const char* cB = (const char*)g.Bt + ((size_t)cur.e * g.b_e_stride) * 2 + (size_t)cur.pn * tstep;
    unsigned vA[2][2], vAn[2][2]; PG8_CALCA(cur, vA);
    PG8_STAGE(PG8_SB(0, 0), cB, voffB); PG8_STAGE(PG8_SB(0, 1), cB + hstep, voffB); PG8_STAGE(PG8_SA(0, 0), Ab, vA[0]); PG8_STAGE(PG8_SA(0, 1), Ab, vA[1]);
    if (wr == 1) PG8_BAR;
    PG8_WAIT_V(2); PG8_BAR;
    PG8_STAGE(PG8_SB(1, 0), cB + kstep, voffB); PG8_STAGE(PG8_SA(1, 0), Ab + kstep, vA[0]); PG8_STAGE(PG8_SB(1, 1), cB + hstep + kstep, voffB);
    PG8_WAIT_V(6); PG8_BAR;
    for (;;) {
        const bool has_next = S.next(ui + 1, nxt);
        const char* nB = has_next ? (const char*)g.Bt + ((size_t)nxt.e * g.b_e_stride) * 2 + (size_t)nxt.pn * tstep : cB;
        if (has_next) { PG8_CALCA(nxt, vAn); } else {
#pragma unroll
            for (int _h = 0; _h < 2; ++_h)
#pragma unroll
                for (int _i = 0; _i < 2; ++_i) vAn[_h][_i] = vA[_h][_i]; }
        for (int t = 0; t < nt; t += 2) {
            const bool last = (t == nt - 2);
            const char* a1 = Ab + (size_t)(t + 1) * kstep;
            const char* a2 = last ? Ab : Ab + (size_t)(t + 2) * kstep; const char* b2 = last ? nB : cB + (size_t)(t + 2) * kstep;
            const char* a3 = a2 + kstep; const char* b3 = b2 + kstep;
            unsigned w2[2][2];
#pragma unroll
            for (int _h = 0; _h < 2; ++_h)
#pragma unroll
                for (int _i = 0; _i < 2; ++_i) w2[_h][_i] = last ? vAn[_h][_i] : vA[_h][_i];
            {
            PG8_LDB(B0, 0, 0); PG8_LDB(B1, 0, 1); PG8_SCHED; PG8_LDA(At, 0, 0); PG8_STAGE(PG8_SA(1, 1), a1, vA[1]);
            PG8_WAIT_V(8); PG8_WAIT_L(0); PG8_BAR; PG8_MMA(0, 0, At, B0); PG8_MMA(0, 1, At, B1); PG8_BAR; PG8_SCHED;
            PG8_LDA(At, 0, 1); PG8_STAGE(PG8_SB(0, 0), b2, voffB); PG8_STAGE(PG8_SB(0, 1), b2 + hstep, voffB); PG8_STAGE(PG8_SA(0, 0), a2, w2[0]);
            PG8_WAIT_V(8); PG8_WAIT_L(0); PG8_BAR; PG8_MMA(1, 0, At, B0); PG8_MMA(1, 1, At, B1); PG8_BAR; PG8_SCHED;
            PG8_LDB(B0, 1, 0); PG8_LDB(B1, 1, 1); PG8_SCHED; PG8_LDA(At, 1, 0); PG8_STAGE(PG8_SA(0, 1), a2, w2[1]);
            PG8_WAIT_V(8); PG8_WAIT_L(0); PG8_BAR; PG8_MMA(0, 0, At, B0); PG8_MMA(0, 1, At, B1); PG8_BAR; PG8_SCHED;
            PG8_LDA(At, 1, 1); PG8_STAGE(PG8_SB(1, 0), b3, voffB); PG8_STAGE(PG8_SB(1, 1), b3 + hstep, voffB); PG8_STAGE(PG8_SA(1, 0), a3, w2[0]);
            PG8_WAIT_V(8); PG8_WAIT_L(0); PG8_BAR; PG8_MMA(1, 0, At, B0); PG8_MMA(1, 1, At, B1); PG8_BAR; PG8_SCHED;
            }
        }
        if constexpr (ALIGN_EPI) { if (wr == 0) PG8_BAR; }
        E(acc, cur, wr, wc, fr, fq);
        if (!has_next) break;
#pragma unroll
        for (int a = 0; a < 2; ++a)
#pragma unroll
            for (int b = 0; b < 2; ++b)
#pragma unroll
                for (int m = 0; m < 4; ++m)
#pragma unroll
                    for (int n = 0; n < 2; ++n) acc[a][b][m][n] = (f32x4){0.f, 0.f, 0.f, 0.f};
        cur = nxt; cB = nB; ++ui;
#pragma unroll
        for (int _h = 0; _h < 2; ++_h)
#pragma unroll
            for (int _i = 0; _i < 2; ++_i) vA[_h][_i] = vAn[_h][_i];
        if constexpr (ALIGN_EPI) { if (wr == 1) PG8_BAR; }
    }
    PG8_WAIT_V(0);
    if constexpr (!ALIGN_EPI) { if (wr == 0) PG8_BAR; }
    PG8_BAR;
#undef PG8_SA
#undef PG8_SB
#undef PG8_STAGE
#undef PG8_LDA
#undef PG8_LDB
#undef PG8_MMA
#undef PG8_WAIT_V
#undef PG8_WAIT_L
#undef PG8_BAR
#undef PG8_SCHED
#undef PG8_CALCA
}
}

namespace attn_body {
using bf16=__hip_bfloat16;
using bf16x8=__attribute__((ext_vector_type(8)))short;
using s16x4=__attribute__((ext_vector_type(4)))short;
using f32x16=__attribute__((ext_vector_type(16)))float;
using u32x4=__attribute__((ext_vector_type(4)))unsigned;
constexpr int BATCH=4,NHEAD=16,NKVH=4,SEQ=4096,SKV=4352,D=64,DM=NHEAD*D,KVP=NKVH*D;
constexpr int NW=8,QBLK=32,QB=QBLK*NW,KVBLK=64,NQB=SEQ/QB;
constexpr int ATTN_PITCH=DM, ATTN_UNIT_ROWS=QB;
__device__ __forceinline__ int crow(int r,int hi){return (r&3)+8*(r>>2)+4*hi;}
#define SBAR() __builtin_amdgcn_sched_barrier(0)
__device__ __forceinline__ void cmask(f32x16&p0,f32x16&p1,int jb,int qrel,int hi){
  const float NEG=-INFINITY; int kb=64*jb+4*hi;
  #pragma unroll
  for(int r=0;r<16;++r){int kv=kb+(r&3)+8*(r>>2); if(kv>qrel)p0[r]=NEG; if(kv+32>qrel)p1[r]=NEG;}
}

constexpr int NSLOT=3, SLOTB=8192;
constexpr int LDS_K=0, LDS_V=NSLOT*SLOTB, LDS_WS=2*NSLOT*SLOTB, LDS_OST=LDS_WS+NW*64*4, LDS_BYTES=LDS_OST+NW*4096;
constexpr float C2=0.125f*1.4426950408889634f;
__device__ __forceinline__ void glds16(const void*gsrc,unsigned lds_dst){unsigned keep;
  asm volatile("s_mov_b32 %0, m0\n\ts_mov_b32 m0, %2\n\ts_nop 0\n\tglobal_load_lds_dwordx4 %1, off\n\ts_mov_b32 m0, %0":"=&s"(keep):"v"(gsrc),"s"(lds_dst):"memory");}
__device__ __forceinline__ float max3f(float a,float b,float c){float r;asm("v_max3_f32 %0, %1, %2, %3":"=v"(r):"v"(a),"v"(b),"v"(c));return r;}
__device__ __forceinline__ float max2f(float a,float b){float r;asm("v_max_f32_e32 %0, %1, %2":"=v"(r):"v"(a),"v"(b));return r;}
__device__ __forceinline__ float fadd_s(float a,float b){float r;asm("v_add_f32_e32 %0, %1, %2":"=v"(r):"v"(a),"v"(b));return r;}
__device__ __forceinline__ float fsub_s(float a,float b){float r;asm("v_sub_f32_e32 %0, %1, %2":"=v"(r):"v"(a),"v"(b));return r;}
typedef float f32x2_t __attribute__((ext_vector_type(2))); typedef __bf16 bf16x2_t __attribute__((ext_vector_type(2)));
__device__ __forceinline__ unsigned cvtpk_s(float lo,float hi){f32x2_t v={lo,hi};bf16x2_t b=__builtin_convertvector(v,bf16x2_t);return __builtin_bit_cast(unsigned,b);}
#define WAIT_BAR(N) asm volatile("s_waitcnt vmcnt(" #N ") lgkmcnt(0)\n\ts_barrier":::"memory")

__device__ __forceinline__ void qkt(f32x16&p0,f32x16&p1,const char*Kslot,const bf16x8*qr,const f32x16&negm,int r32,int hi){
  const char*kb=Kslot+hi*1024+r32*16;
  #pragma unroll
  for(int d0=0;d0<4;++d0){
    const bf16x8 b0=*reinterpret_cast<const bf16x8*>(kb+d0*2048);
    const bf16x8 b1=*reinterpret_cast<const bf16x8*>(kb+d0*2048+512);
    if(d0==0){p0=__builtin_amdgcn_mfma_f32_32x32x16_bf16(b0,qr[0],negm,0,0,0);p1=__builtin_amdgcn_mfma_f32_32x32x16_bf16(b1,qr[0],negm,0,0,0);}
    else{p0=__builtin_amdgcn_mfma_f32_32x32x16_bf16(b0,qr[d0],p0,0,0,0);p1=__builtin_amdgcn_mfma_f32_32x32x16_bf16(b1,qr[d0],p1,0,0,0);}}
}
typedef __attribute__((address_space(3))) const char* lds_cptr;
typedef short v4i16_t __attribute__((ext_vector_type(4)));
__device__ __forceinline__ void kload8(bf16x8*kf,lds_cptr kp){
  kf[0]=*(const __attribute__((address_space(3))) bf16x8*)(kp);      kf[1]=*(const __attribute__((address_space(3))) bf16x8*)(kp+512);
  kf[2]=*(const __attribute__((address_space(3))) bf16x8*)(kp+2048); kf[3]=*(const __attribute__((address_space(3))) bf16x8*)(kp+2560);
  kf[4]=*(const __attribute__((address_space(3))) bf16x8*)(kp+4096); kf[5]=*(const __attribute__((address_space(3))) bf16x8*)(kp+4608);
  kf[6]=*(const __attribute__((address_space(3))) bf16x8*)(kp+6144); kf[7]=*(const __attribute__((address_space(3))) bf16x8*)(kp+6656);
}
__device__ __forceinline__ void kload2(bf16x8*kf,lds_cptr kp,int j){ kf[2*j]=*(const __attribute__((address_space(3))) bf16x8*)(kp+j*2048); kf[2*j+1]=*(const __attribute__((address_space(3))) bf16x8*)(kp+j*2048+512); }
__device__ __forceinline__ s16x4 vtr(lds_cptr p){ return __builtin_bit_cast(s16x4,__builtin_amdgcn_ds_read_tr16_b64_v4i16((__attribute__((address_space(3))) v4i16_t*)p)); }
__device__ __forceinline__ float rowmax(const f32x16&p0,const f32x16&p1){
  float a=max3f(p0[0],p0[1],p1[0]),b=max3f(p0[2],p0[3],p1[1]);a=max3f(a,p1[2],p1[3]);
  #pragma unroll
  for(int r=4;r<16;r+=4){a=max3f(a,p0[r],p0[r+1]);b=max3f(b,p0[r+2],p0[r+3]);a=max3f(a,p1[r],p1[r+1]);b=max3f(b,p1[r+2],p1[r+3]);}
  const float m=max2f(a,b);
  auto rr=__builtin_amdgcn_permlane32_swap(__float_as_uint(m),__float_as_uint(m),false,false);
  return max2f(__uint_as_float(rr[0]),__uint_as_float(rr[1]));
}
__device__ __forceinline__ void pv(f32x16*o,int vb,bf16x8 pa0,bf16x8 pa1,bf16x8 pa2,bf16x8 pa3){
  #pragma unroll
  for(int d0=0;d0<2;++d0){s16x4 lo[4],hi[4];
    #pragma unroll
    for(int ks=0;ks<4;++ks){
      asm volatile("ds_read_b64_tr_b16 %0,%1 offset:%c2":"=&v"(lo[ks]):"v"(vb),"i"(d0*4096+ks*1024):"memory");
      asm volatile("ds_read_b64_tr_b16 %0,%1 offset:%c2":"=&v"(hi[ks]):"v"(vb),"i"(d0*4096+ks*1024+512):"memory");}
    asm volatile("s_waitcnt lgkmcnt(0)":::"memory");SBAR();
    #define PK(k) (bf16x8){lo[k][0],lo[k][1],lo[k][2],lo[k][3],hi[k][0],hi[k][1],hi[k][2],hi[k][3]}
    o[d0]=__builtin_amdgcn_mfma_f32_32x32x16_bf16(pa0,PK(0),o[d0],0,0,0);
    o[d0]=__builtin_amdgcn_mfma_f32_32x32x16_bf16(pa1,PK(1),o[d0],0,0,0);
    o[d0]=__builtin_amdgcn_mfma_f32_32x32x16_bf16(pa2,PK(2),o[d0],0,0,0);
    o[d0]=__builtin_amdgcn_mfma_f32_32x32x16_bf16(pa3,PK(3),o[d0],0,0,0);
    #undef PK
  }
}

#ifndef ATTN_STORE16
#define ATTN_STORE16(p,v) (*(u32x4*)(p)=(v))
#endif
template<int THRL> __device__ __forceinline__ void attn_unit(const int tid,int b,int h,int qb,const bf16*Q,const bf16*__restrict__ K,const bf16*__restrict__ V,bf16*O,char*shm){
  const int lane=tid&63,r32=lane&31,hi=lane>>5; const int wid=__builtin_amdgcn_readfirstlane(tid>>6);
  const long rowbase=(long)b*SEQ; const int q0=qb*QB;
  const bf16*Qw=Q+(rowbase+q0+wid*QBLK)*DM+h*D;
  const bf16*Kh=K+(long)b*SKV*KVP+(h>>2)*D,*Vh=V+(long)b*SKV*KVP+(h>>2)*D;
  const unsigned lds0=(unsigned)(uintptr_t)shm;
  float*wsf=(float*)(shm+LDS_WS)+wid*64;
  const bf16*ksrc=Kh+(long)lane*KVP+wid*8;
  const bf16*vsrc=Vh+(long)(16*(wid&3)+(lane>>2))*KVP+(wid>>2)*32+(lane&3)*8;
  const unsigned kdst=lds0+LDS_K+wid*1024, vdst=lds0+LDS_V+wid*1024;
  #define DMA_K(t,slot) glds16(ksrc+(long)(t)*KVBLK*KVP,(unsigned)__builtin_amdgcn_readfirstlane(kdst+(slot)))
  #define DMA_V(t,slot) glds16(vsrc+(long)(t)*KVBLK*KVP,(unsigned)__builtin_amdgcn_readfirstlane(vdst+(slot)))
  const int vb0=(int)(lds0+LDS_V)+((lane>>4)&1)*32+(lane&3)*8+(4*hi+((lane&15)>>2))*64;
  const char*Kbase=shm+LDS_K; bf16x8 kf[8];
  const lds_cptr shm3=(lds_cptr)shm; const lds_cptr kp0=shm3+LDS_K+hi*1024+r32*16; const lds_cptr vp0=shm3+LDS_V+((lane>>4)&1)*32+(lane&3)*8+(4*hi+((lane&15)>>2))*64;
  int NT=SKV/KVBLK; asm volatile("":"+s"(NT));
  DMA_K(0,0);DMA_V(0,0);DMA_K(1,SLOTB);
  bf16x8 qr[4];
  #pragma unroll
  for(int d0=0;d0<4;++d0)qr[d0]=*reinterpret_cast<const bf16x8*>(&Qw[(long)r32*DM+d0*16+hi*8]);
  float mhat=0.f,l_reg=0.f;f32x16 o[2];o[0]=f32x16{};o[1]=f32x16{};f32x16 negm=f32x16{};asm volatile("":"+v"(negm));
  #define CMASK(P0,P1,t) do{}while(0)
  bool resc=false;
  #define START(P0,P1) do{ const float rm=rowmax(P0,P1); resc=false; \
    { const float dl=rm; mhat=fadd_s(mhat,dl); \
      _Pragma("unroll") for(int r=0;r<16;++r){P0[r]=fsub_s(P0[r],dl);P1[r]=fsub_s(P1[r],dl);} \
      _Pragma("unroll") for(int r=0;r<16;++r)negm[r]=-mhat; asm volatile("":"+v"(negm)); } \
    _Pragma("unroll") for(int r=0;r<16;++r)P0[r]=__builtin_amdgcn_exp2f(P0[r]); }while(0)
  #define RESC() do{ if(resc){ asm volatile("s_waitcnt lgkmcnt(0)":::"memory"); \
      _Pragma("unroll") for(int d_=0;d_<2;++d_) _Pragma("unroll") for(int r=0;r<16;++r)o[d_][r]*=wsf[crow(r,hi)]; } }while(0)
  f32x16 pA0,pA1,pB0,pB1;
  int sl_prev=0,sl_cur=0,sl_next=SLOTB;
  #define ROT() do{sl_prev=sl_cur;sl_cur=sl_next;sl_next=(sl_next==(NSLOT-1)*SLOTB)?0:sl_next+SLOTB;}while(0)
  DMA_K(2,2*SLOTB);
  WAIT_BAR(3);
  qkt(pA0,pA1,Kbase,qr,negm,r32,hi);asm volatile("s_nop 15\n\ts_nop 7":"+v"(pA0),"+v"(pA1));CMASK(pA0,pA1,0);
  START(pA0,pA1);
  _Pragma("unroll") for(int r=0;r<16;++r)pA1[r]=__builtin_amdgcn_exp2f(pA1[r]);
  WAIT_BAR(0);
  DMA_K(3,0);DMA_V(1,SLOTB);
  ROT();
  kload8(kf,kp0+sl_cur);
  WAIT_BAR(2);
  s16x4 vlo[8],vhi[8]; u32x4 pw0,pw1,pw2,pw3;
  #define PKW(P,B) cvtpk_s(P[B],P[B+1])
  #define PAF(k) __builtin_bit_cast(bf16x8,pw##k)
  #define VFR(i) (bf16x8){vlo[i][0],vlo[i][1],vlo[i][2],vlo[i][3],vhi[i][0],vhi[i][1],vhi[i][2],vhi[i][3]}
  #define PIN(x) asm volatile("":"+v"(x))
  #define MX3(a,b,c) __builtin_fmaxf(__builtin_fmaxf((a),(b)),(c))
  #define GAPA(MF,A0,A1,A2,A3,W0,W1,PW) do{ MF; sacc+=A0; sacc+=A1; sacc+=A2; sacc+=A3; PIN(sacc); W0; W1; PIN(PW); SBAR(); }while(0)
  #define EX(v) __builtin_amdgcn_exp2f(v)
  #define GAPB(MF,X,B) do{ MF; X[B]=EX(X[B]); X[B+1]=EX(X[B+1]); X[B+2]=EX(X[B+2]); X[B+3]=EX(X[B+3]); PIN(X); SBAR(); }while(0)
  #define VRD(i) do{ vlo[i]=vtr(vp_+(((i)>>2)*4096+((i)&3)*1024)); vhi[i]=vtr(vp_+(((i)>>2)*4096+((i)&3)*1024+512)); }while(0)
  #define KRD(G,j) do{ if(G){ kload2(kf,kp0+sl_next,j); SBAR(); } }while(0)
  #define STEP(C0,C1,P0,P1,t,GK,GV,GL) do{ SBAR(); \
    const lds_cptr vp_=vp0+sl_prev; \
    VRD(0); SBAR(); float sacc=(P0[0]+P0[1]); \
    GAPA(C0=__builtin_amdgcn_mfma_f32_32x32x16_bf16(kf[0],qr[0],negm,0,0,0), P0[2],P0[3],P0[4],P0[5],     pw0[0]=PKW(P0,0), pw0[1]=PKW(P0,2), pw0); \
    VRD(4); SBAR(); GAPA(C1=__builtin_amdgcn_mfma_f32_32x32x16_bf16(kf[1],qr[0],negm,0,0,0), P0[6],P0[7],P0[8],P0[9],     pw0[2]=PKW(P0,4), pw0[3]=PKW(P0,6), pw0); \
    VRD(1); SBAR(); GAPA(C0=__builtin_amdgcn_mfma_f32_32x32x16_bf16(kf[2],qr[1],C0,0,0,0),   P0[10],P0[11],P0[12],P0[13], pw1[0]=PKW(P0,8), pw1[1]=PKW(P0,10), pw1); \
    VRD(5); SBAR(); GAPA(C1=__builtin_amdgcn_mfma_f32_32x32x16_bf16(kf[3],qr[1],C1,0,0,0),   P0[14],P0[15],P1[0],P1[1],   pw1[2]=PKW(P0,12),pw1[3]=PKW(P0,14), pw1); \
    VRD(2); SBAR(); GAPA(C0=__builtin_amdgcn_mfma_f32_32x32x16_bf16(kf[4],qr[2],C0,0,0,0),   P1[2],P1[3],P1[4],P1[5],     pw2[0]=PKW(P1,0), pw2[1]=PKW(P1,2), pw2); \
    VRD(6); SBAR(); GAPA(C1=__builtin_amdgcn_mfma_f32_32x32x16_bf16(kf[5],qr[2],C1,0,0,0),   P1[6],P1[7],P1[8],P1[9],     pw2[2]=PKW(P1,4), pw2[3]=PKW(P1,6), pw2); \
    VRD(3); SBAR(); GAPA(C0=__builtin_amdgcn_mfma_f32_32x32x16_bf16(kf[6],qr[3],C0,0,0,0),   P1[10],P1[11],P1[12],P1[13], pw3[0]=PKW(P1,8), pw3[1]=PKW(P1,10), pw3); \
    VRD(7); SBAR(); GAPA(C1=__builtin_amdgcn_mfma_f32_32x32x16_bf16(kf[7],qr[3],C1,0,0,0),   P1[14],P1[15],0.f,0.f,       pw3[2]=PKW(P1,12),pw3[3]=PKW(P1,14), pw3); \
    l_reg+=sacc; \
    if(GK){DMA_K((t)+3,sl_cur);} if(GV){DMA_V((t)+1,sl_next);} \
    CMASK(C0,C1,t); \
    { float a=MX3(C0[0],C0[1],C1[0]),b=MX3(C0[2],C0[3],C1[1]); a=MX3(a,C1[2],C1[3]); \
      _Pragma("unroll") for(int r=4;r<16;r+=4){a=MX3(a,C0[r],C0[r+1]);b=MX3(b,C0[r+2],C0[r+3]);a=MX3(a,C1[r],C1[r+1]);b=MX3(b,C1[r+2],C1[r+3]);} \
      float rm=__builtin_fmaxf(a,b); { auto rr=__builtin_amdgcn_permlane32_swap(__float_as_uint(rm),__float_as_uint(rm),false,false); rm=__builtin_fmaxf(__uint_as_float(rr[0]),__uint_as_float(rr[1])); } \
      resc=false; \
      if(__builtin_expect(__any(rm>(float)THRL),0)){ const float dl=__builtin_fmaxf(rm,0.f); mhat+=dl; \
        _Pragma("unroll") for(int r=0;r<16;++r){C0[r]-=dl;C1[r]-=dl;} \
        _Pragma("unroll") for(int r=0;r<16;++r)negm[r]=-mhat; asm volatile("":"+v"(negm)); \
        const float f=__builtin_amdgcn_exp2f(-dl); l_reg*=f; if(hi==0)wsf[r32]=f; resc=true; } } \
    SBAR(); \
    GAPB(o[0]=__builtin_amdgcn_mfma_f32_32x32x16_bf16(PAF(0),VFR(0),o[0],0,0,0), C0,0); \
    GAPB(o[1]=__builtin_amdgcn_mfma_f32_32x32x16_bf16(PAF(0),VFR(4),o[1],0,0,0), C0,4); \
    KRD(GL,0); GAPB(o[0]=__builtin_amdgcn_mfma_f32_32x32x16_bf16(PAF(1),VFR(1),o[0],0,0,0), C0,8); \
    KRD(GL,1); GAPB(o[1]=__builtin_amdgcn_mfma_f32_32x32x16_bf16(PAF(1),VFR(5),o[1],0,0,0), C0,12); \
    KRD(GL,2); GAPB(o[0]=__builtin_amdgcn_mfma_f32_32x32x16_bf16(PAF(2),VFR(2),o[0],0,0,0), C1,0); \
    KRD(GL,3); GAPB(o[1]=__builtin_amdgcn_mfma_f32_32x32x16_bf16(PAF(2),VFR(6),o[1],0,0,0), C1,4); \
    GAPB(o[0]=__builtin_amdgcn_mfma_f32_32x32x16_bf16(PAF(3),VFR(3),o[0],0,0,0), C1,8); \
    GAPB(o[1]=__builtin_amdgcn_mfma_f32_32x32x16_bf16(PAF(3),VFR(7),o[1],0,0,0), C1,12); \
    }while(0)
  int t=1;
  #undef CMASK
  #define CMASK(P0,P1,t) do{}while(0)
  for(;t+5<NT;t+=2){
    STEP(pB0,pB1,pA0,pA1,t,true,true,true);     WAIT_BAR(2); RESC(); ROT();
    STEP(pA0,pA1,pB0,pB1,t+1,true,true,true);   WAIT_BAR(2); RESC(); ROT();
  }
  #undef CMASK
  #define CMASK(P0,P1,t) do{}while(0)
  #define ENDW(tt) do{ if((tt)+3<NT){WAIT_BAR(2);} else if((tt)+2<NT){WAIT_BAR(1);} else {WAIT_BAR(0);} }while(0)
  for(;t+1<NT;t+=2){
    STEP(pB0,pB1,pA0,pA1,t,(t+3<NT),(t+1<NT),(t+1<NT));       ENDW(t);   RESC(); ROT();
    STEP(pA0,pA1,pB0,pB1,t+1,(t+4<NT),(t+2<NT),(t+2<NT));     ENDW(t+1); RESC(); ROT();
  }
  STEP(pB0,pB1,pA0,pA1,NT-1,false,false,false); RESC();
  { float sacc=pB0[0]+pB0[1]; _Pragma("unroll") for(int r=2;r<16;++r)sacc+=pB0[r]; _Pragma("unroll") for(int r=0;r<16;++r)sacc+=pB1[r]; l_reg+=sacc;
    pw0=(u32x4){PKW(pB0,0),PKW(pB0,2),PKW(pB0,4),PKW(pB0,6)};pw1=(u32x4){PKW(pB0,8),PKW(pB0,10),PKW(pB0,12),PKW(pB0,14)};pw2=(u32x4){PKW(pB1,0),PKW(pB1,2),PKW(pB1,4),PKW(pB1,6)};pw3=(u32x4){PKW(pB1,8),PKW(pB1,10),PKW(pB1,12),PKW(pB1,14)};
    SBAR(); pv(o,vb0+sl_cur,PAF(0),PAF(1),PAF(2),PAF(3)); }
  #undef PKW
  #undef PAF
  #undef VFR
  #undef PIN
  #undef MX3
  #undef GAPA
  #undef GAPB
  #undef EX
  #undef VRD
  #undef KRD
  #undef STEP
  #undef ENDW
  {auto rr=__builtin_amdgcn_permlane32_swap(__float_as_uint(l_reg),__float_as_uint(l_reg),false,false);l_reg=__uint_as_float(rr[0])+__uint_as_float(rr[1]);}
  if(hi==0)wsf[32+r32]=l_reg;asm volatile("s_waitcnt lgkmcnt(0)":::"memory");
  float rli[16];
  #pragma unroll
  for(int r=0;r<16;++r)rli[r]=__builtin_amdgcn_rcpf(wsf[32+crow(r,hi)]);
  bf16*Ow=O+(rowbase+q0+wid*QBLK)*DM+h*D;
  { bf16*stg=(bf16*)(shm+LDS_OST)+wid*2048;
    #pragma unroll
    for(int r=0;r<16;++r){const int orow=crow(r,hi);
      #pragma unroll
      for(int d0=0;d0<2;++d0)stg[orow*64+d0*32+r32]=__float2bfloat16(o[d0][r]*rli[r]);}
    asm volatile("s_waitcnt lgkmcnt(0)":::"memory");
    #pragma unroll
    for(int i=0;i<4;++i){const int row=i*8+(lane>>3),ch=lane&7; const u32x4 v=*(const u32x4*)(stg+row*64+ch*8); ATTN_STORE16(Ow+(long)row*DM+ch*8,v);} }
  asm volatile("s_waitcnt lgkmcnt(0)\n\ts_barrier":::"memory");
  #undef DMA_K
  #undef DMA_V
  #undef CMASK
  #undef START
  #undef RESC
  #undef ROT
}
constexpr int ATTN_LDS_BYTES=LDS_BYTES;
struct AttnTensors { const bf16* Q; const bf16* K; const bf16* V; bf16* O; };
struct AttnUnit { int bh; int qb; };
struct StaticOrder {
  int vcu,G,per;
  __device__ __forceinline__ explicit StaticOrder(int grid,int vcu_):vcu(vcu_),G(grid),per((BATCH*NHEAD*NQB+grid-1)/grid){}
  __device__ __forceinline__ bool next(int i,AttnUnit&u)const{ if(i>=per)return false; const int idx=vcu*per+i; if(idx>=BATCH*NHEAD*NQB)return false; u.bh=idx/NQB; u.qb=idx%NQB; return true; }
  __device__ __forceinline__ void a_ready(const AttnUnit&)const{}
  __device__ __forceinline__ void done(const AttnUnit&)const{}
};
template<class Sched,int THRL=8> __device__ __forceinline__ void attn_phase(const int tid,char*lds,const AttnTensors&T,const Sched&S){
  AttnUnit u;
  for(int i=0;S.next(i,u);++i){ S.a_ready(u); attn_unit<THRL>(tid,u.bh/NHEAD,u.bh%NHEAD,u.qb,T.Q,T.K,T.V,T.O,lds); S.done(u); }
}
#undef SBAR
#undef WAIT_BAR
}

constexpr int NWAVES = 8;
#ifndef MK_PER_PHASE
#define MK_PER_PHASE 0
#endif
#ifndef DBG_STOP
#define DBG_STOP 99
#endif
constexpr int NPH = 32;

constexpr int D = 1024, NB = 4, SEQ = 4096, TL = NB * SEQ, CTXL = 256, TC = NB * CTXL, TT = TL + TC;
constexpr int ADIM = 2048, FF = 2816, ED = 3584, NE = 8, QKVW = 1536, SKV = CTXL + SEQ;
constexpr int MPAD = 136 * 256;
constexpr float EPS = 1e-6f;

constexpr size_t MiB = 1u << 20, KiB = 1u << 10;
constexpr size_t WS_CTL = 0, CTL_ZERO_BYTES = 64 * KiB;
constexpr size_t WS_MODS = 1 * MiB;
constexpr size_t WS_TAB = 2 * MiB;
constexpr size_t WS_TOKE = 2 * MiB + 64 * KiB, WS_TOKS = WS_TOKE + 128 * KiB, WS_TOKG = WS_TOKS + 128 * KiB, WS_PROW = WS_TOKG + 128 * KiB, WS_GW = WS_PROW + 128 * KiB;
constexpr size_t WS_RSP = 4 * MiB;
constexpr size_t W_IN = 8 * MiB, W_OUT = 24 * MiB, W_QKV = 32 * MiB, W_O = 35 * MiB, W_P = 37 * MiB, W_GU = 38 * MiB, W_DN = 60 * MiB, M_GU = 71 * MiB, M_DN = 295 * MiB;
constexpr size_t WS_XS = 407 * MiB, WS_H = 475 * MiB, WS_BIG = 509 * MiB, WS_R2 = 747 * MiB, WS_END = 815 * MiB;
constexpr size_t WS_MODP = WS_R2;
static_assert(WS_GW + MPAD * 4 <= 4 * MiB && WS_MODS + 4 * 5 * 6144 * 4 <= WS_TAB && WS_RSP + (size_t)TT * 32 * 4 <= W_IN, "small-buffer map");
static_assert(M_DN + (size_t)16 * D * ED * 2 == WS_XS && WS_XS + (size_t)TT * D * 4 == WS_H && WS_H + (size_t)TT * D * 2 == WS_BIG && WS_BIG + (size_t)MPAD * ED * 2 == WS_R2 && WS_R2 + (size_t)MPAD * D * 2 == WS_END, "d_ws map");
constexpr int CW_TMO = 0, CW_CODE = 1, CW_BAR = 4096, CW_CNT = 8192;

constexpr int RING_OFF = 0, RING_BYTES = 131072;
constexpr int LDSCTL_OFF = RING_BYTES, MISC_OFF = LDSCTL_OFF + 320;
constexpr int LDS_BYTES = 147456;
static_assert(MISC_OFF + 128 <= LDS_BYTES, "LDS map");

#define GAS __attribute__((address_space(1)))
#define LAS __attribute__((address_space(3)))
typedef unsigned short bf16;
typedef unsigned v4u __attribute__((ext_vector_type(4)));
typedef float f32x4 __attribute__((ext_vector_type(4)));
typedef short bf16x8 __attribute__((ext_vector_type(8)));
typedef GAS unsigned gu32;
typedef GAS unsigned long long gu64;
#define RLX_AGENT __ATOMIC_RELAXED, __HIP_MEMORY_SCOPE_AGENT
#define LDS_WAIT() asm volatile("s_waitcnt lgkmcnt(0)" ::: "memory")
#define VM_WAIT() asm volatile("s_waitcnt vmcnt(0)" ::: "memory")
__device__ __forceinline__ unsigned long long rt() { return __builtin_amdgcn_s_memrealtime(); }
__device__ __forceinline__ unsigned f2bf(float f) { unsigned u = __builtin_bit_cast(unsigned, f); return (u + 0x7fffu + ((u >> 16) & 1u)) >> 16; }
__device__ __forceinline__ unsigned pk2(float lo, float hi) { return f2bf(lo) | (f2bf(hi) << 16); }

#define XB_TMO      128
#define XB_XCNT(j)  (256  + 64 * (j))
#define XB_XSUB(j)  (1280 + 64 * (j))
#define XB_XGEN(j)  (2304 + 64 * (j))
#define XB_TOP      3328
#define XB_TOPGEN   3392
#define XCD_BAR_WORDS 3456
#define XB_SPIN_CAP (1u << 18)

__device__ __forceinline__ unsigned xb_ld(unsigned* p)              { return __hip_atomic_load(p, __ATOMIC_RELAXED, __HIP_MEMORY_SCOPE_AGENT); }
__device__ __forceinline__ unsigned xb_add(unsigned* p, unsigned v) { return __hip_atomic_fetch_add(p, v, __ATOMIC_RELAXED, __HIP_MEMORY_SCOPE_AGENT); }
__device__ __forceinline__ unsigned xb_xcc_id() { return (unsigned)__builtin_amdgcn_s_getreg((3 << 11) | 20) & 0xFu; }
#define XB_SPIN(cond, bar) do { unsigned _sp = 0; while (cond) { __builtin_amdgcn_s_sleep(1); \
    if ((++_sp & 255u) == 0u) { if (xb_ld(&(bar)[XB_TMO])) break; if (_sp > XB_SPIN_CAP) { atomicAdd(&(bar)[XB_TMO], 1u); break; } } } } while (0)

struct XcdBarrier {
    unsigned* bar; unsigned x;
    volatile LAS unsigned* st;
};

__device__ __forceinline__ XcdBarrier xcd_barrier_post(unsigned* bar, volatile LAS unsigned* st, const int tid) {
    XcdBarrier b; b.bar = bar; b.x = xb_xcc_id(); b.st = st;
    if (tid == 0) (void)xb_add(&bar[XB_XCNT(b.x)], 1u);
    return b;
}
__device__ __forceinline__ void xcd_barrier_complete(unsigned* bar, unsigned x, unsigned& nloc, unsigned& nx) {
    const unsigned G = gridDim.x * gridDim.y * gridDim.z;
    unsigned sum, cnt, mine, sp = 0u;
    for (;;) {
        sum = 0u; cnt = 0u; mine = 0u;
#pragma unroll
        for (unsigned j = 0; j < 16; ++j) { const unsigned c = xb_ld(&bar[XB_XCNT(j)]); sum += c; cnt += (c > 0u) ? 1u : 0u; mine = (j == x) ? c : mine; }
        if (sum == G) break;
        __builtin_amdgcn_s_sleep(1);
        if ((++sp & 255u) == 0u) { if (xb_ld(&bar[XB_TMO])) break; if (sp > XB_SPIN_CAP) { atomicAdd(&bar[XB_TMO], 1u); break; } }
    }
    nloc = mine > 0u ? mine : 1u; nx = cnt > 0u ? cnt : 1u;
}

__device__ __forceinline__ void xcd_barrier(const XcdBarrier& b, const int tid) {
    asm volatile("s_waitcnt vmcnt(0)" ::: "memory");
    __syncthreads();
    if (tid == 0) {
        unsigned* bar = b.bar;
        __builtin_amdgcn_s_waitcnt(0);
        unsigned nloc = b.st[0], nx = b.st[1];
        if (nloc == 0u) { xcd_barrier_complete(bar, b.x, nloc, nx); b.st[0] = nloc; b.st[1] = nx; }
        const unsigned old = xb_add(&bar[XB_XSUB(b.x)], 1u);
        const unsigned gen = old / nloc;
        if (old + 1u == (gen + 1u) * nloc) {
            __builtin_amdgcn_fence(__ATOMIC_RELEASE, "agent");
            asm volatile("s_waitcnt vmcnt(0)" ::: "memory");
            const unsigned og = xb_add(&bar[XB_TOP], 1u);
            const unsigned tg = og / nx;
            if (og + 1u == (tg + 1u) * nx) xb_add(&bar[XB_TOPGEN], 1u);
            else XB_SPIN(xb_ld(&bar[XB_TOPGEN]) == tg, bar);
            __builtin_amdgcn_fence(__ATOMIC_ACQUIRE, "agent");
            xb_add(&bar[XB_XGEN(b.x)], 1u);
            asm volatile("s_waitcnt vmcnt(0)" ::: "memory");
        } else {
            XB_SPIN(xb_ld(&bar[XB_XGEN(b.x)]) == gen, bar);
            __builtin_amdgcn_fence(__ATOMIC_ACQUIRE, "agent");
            asm volatile("s_waitcnt vmcnt(0)" ::: "memory");
        }
    }
    __syncthreads();
}


typedef pg8::f32x2 f32x2; typedef pg8::u32x2 u32x2; typedef pg8::u32x4 u32x4;
using pg8::cvt_pk_bf16; using pg8::bf_lo; using pg8::bf_hi;

__device__ __forceinline__ float wave_sum(float v) {
#pragma unroll
    for (int o = 1; o < 64; o <<= 1) v += __shfl_xor(v, o);
    return v;
}

__device__ __forceinline__ void transpose_item(const float* __restrict__ W, int K, int N, bf16* WT, int kb, int nb, int prow0, LAS float* scr, int lane) {
    const int k0 = 64 * kb, n0 = 32 * nb;
#pragma unroll 8
    for (int i = 0; i < 32; ++i) { const int kk = 2 * i + (lane >> 5); scr[kk * 33 + (lane & 31)] = W[(size_t)(k0 + kk) * N + n0 + (lane & 31)]; }
    LDS_WAIT(); asm volatile("" ::: "memory");
    const int c = lane & 7;
#pragma unroll
    for (int j = 0; j < 4; ++j) { const int n = (lane >> 3) + 8 * j; const LAS float* s = scr + (8 * c) * 33 + n;
        v4u o; o.x = pk2(s[0 * 33], s[1 * 33]); o.y = pk2(s[2 * 33], s[3 * 33]); o.z = pk2(s[4 * 33], s[5 * 33]); o.w = pk2(s[6 * 33], s[7 * 33]);
        *(GAS v4u*)(WT + (size_t)(prow0 + n) * K + k0 + 8 * c) = o; }
    LDS_WAIT(); asm volatile("" ::: "memory");
}
__device__ __forceinline__ int gu_row(int c0, int up) { return (c0 >> 7) * 256 + (c0 & 127) + (up ? 128 : 0); }
__device__ __forceinline__ int qkv_row(int l0) { const int pn = l0 >> 8, wc = (l0 & 255) >> 6, bj = (l0 & 63) >> 5; return 256 * pn + 128 * bj + 32 * wc; }

struct In {
    const float *x, *c, *ctx, *c_ctx, *ada_w, *ada_b, *norm_g, *a_w_in, *a_v_g, *a_ws, *a_bs, *a_w_out, *b_w_qkv, *b_q_g, *b_k_g, *b_w_o, *p_w, *p_scale,
                *f_w_gate, *f_w_up, *f_w_down, *m_router, *m_w_gate, *m_w_up, *m_w_down;
};

__device__ __forceinline__ void p1_convert(const In& I, unsigned char* ws, LAS unsigned char* lds, int lane, int wave, int G) {
    LAS float* scr = (LAS float*)(lds + RING_OFF + wave * 16384);
    const int gw = (int)blockIdx.x * NWAVES + wave, NGW = G * NWAVES;
    for (int it = gw; it < 4 * 5 * 6144 / 256; it += NGW) { const int idx = it * 256 + lane * 4, i = idx / (5 * 6144), col = idx % 6144;
        f32x4 a = *(const f32x4*)(I.ada_b + i * 6144 + col);
#pragma unroll
        for (int kc = 0; kc < 8; ++kc) a = a + *(const f32x4*)((const float*)(ws + WS_MODP) + (size_t)kc * (4 * 5 * 6144) + idx);
        *(f32x4*)((float*)(ws + WS_MODS) + idx) = a; }
    constexpr int IPM = 1792, IPE = 3 * IPM, NMOE = 16 * IPE;
    for (int it = gw; it < NMOE; it += NGW) {
        const int le = it / IPE, r = it - le * IPE, which = r / IPM, q = r - which * IPM;
        if (which < 2) { const int kb = q / 112, nb = q - kb * 112; const float* W = (which ? I.m_w_up : I.m_w_gate) + (size_t)le * D * ED;
            transpose_item(W, D, ED, (bf16*)(ws + M_GU) + (size_t)le * 2 * ED * D, kb, nb, gu_row(32 * nb, which), scr, lane); }
        else { const int kb = q >> 5, nb = q & 31; transpose_item(I.m_w_down + (size_t)le * ED * D, ED, D, (bf16*)(ws + M_DN) + (size_t)le * D * ED, kb, nb, 32 * nb, scr, lane); }
    }
    constexpr int I_WIN = 16 * 128, I_WOUT = 32 * 32, I_QKV = 16 * 48, I_WO = 16 * 32, I_PW = 4 * 8, I_FG = 16 * 88, I_FD = 44 * 32;
    constexpr int NSM = 2 * I_WIN + 2 * I_WOUT + I_QKV + I_WO + 4 * I_PW + 4 * I_FG + 2 * I_FD;
    for (int it = gw; it < NSM; it += NGW) {
        int r = it;
        if (r < 2 * I_WIN) { const int j = r / I_WIN, q = r % I_WIN; transpose_item(I.a_w_in + (size_t)j * D * 4096, D, 4096, (bf16*)(ws + W_IN) + (size_t)j * 4096 * D, q / 128, q % 128, 32 * (q % 128), scr, lane); continue; } r -= 2 * I_WIN;
        if (r < 2 * I_WOUT) { const int j = r / I_WOUT, q = r % I_WOUT; transpose_item(I.a_w_out + (size_t)j * ADIM * D, ADIM, D, (bf16*)(ws + W_OUT) + (size_t)j * D * ADIM, q / 32, q % 32, 32 * (q % 32), scr, lane); continue; } r -= 2 * I_WOUT;
        if (r < I_QKV) { transpose_item(I.b_w_qkv, D, QKVW, (bf16*)(ws + W_QKV), r / 48, r % 48, qkv_row(32 * (r % 48)), scr, lane); continue; } r -= I_QKV;
        if (r < I_WO) { transpose_item(I.b_w_o, D, D, (bf16*)(ws + W_O), r / 32, r % 32, 32 * (r % 32), scr, lane); continue; } r -= I_WO;
        if (r < 4 * I_PW) { const int j = r / I_PW, q = r % I_PW; transpose_item(I.p_w + (size_t)j * 65536, 256, 256, (bf16*)(ws + W_P) + (size_t)j * 65536, q / 8, q % 8, 32 * (q % 8), scr, lane); continue; } r -= 4 * I_PW;
        if (r < 4 * I_FG) { const int f = r / (2 * I_FG), which = (r / I_FG) & 1, q = r % I_FG; const float* W = (which ? I.f_w_up : I.f_w_gate) + (size_t)f * D * FF;
            transpose_item(W, D, FF, (bf16*)(ws + W_GU) + (size_t)f * 2 * FF * D, q / 88, q % 88, gu_row(32 * (q % 88), which), scr, lane); continue; } r -= 4 * I_FG;
        { const int f = r / I_FD, q = r % I_FD; transpose_item(I.f_w_down + (size_t)f * FF * D, FF, D, (bf16*)(ws + W_DN) + (size_t)f * D * FF, q / 32, q % 32, 32 * (q % 32), scr, lane); }
    }
}
__device__ __forceinline__ void p0_adaln(const float* cvec, const float* cctx, const float* ada_w, unsigned char* ws, int lane, int wave, int G) {
    const int gw = (int)blockIdx.x * NWAVES + wave, NGW = G * NWAVES;
    for (int it = gw; it < 4 * 24 * 8; it += NGW) {
        const int i = it / 192, r = it % 192, cb = r >> 3, kc = r & 7;
        float sv[5][2];
#pragma unroll
        for (int b = 0; b < 5; ++b)
#pragma unroll
            for (int h = 0; h < 2; ++h) { const float xv = (b < 4 ? cvec + b * D : cctx)[kc * 128 + h * 64 + lane]; sv[b][h] = xv * pg8::sigmoidf_(xv); }
        const float* Wp = ada_w + (size_t)i * D * 6144 + (size_t)(kc * 128) * 6144 + cb * 256 + lane * 4;
        f32x4 a[5];
#pragma unroll
        for (int b = 0; b < 5; ++b) a[b] = (f32x4){0.f, 0.f, 0.f, 0.f};
#pragma unroll
        for (int h = 0; h < 2; ++h) {
#pragma unroll 8
            for (int kk = 0; kk < 64; ++kk) { const f32x4 w = *(const f32x4*)(Wp + (size_t)(h * 64 + kk) * 6144);
#pragma unroll
                for (int b = 0; b < 5; ++b) { const float s = __shfl(sv[b][h], kk); a[b] = a[b] + w * s; } }
        }
        const int col = cb * 256 + lane * 4;
#pragma unroll
        for (int b = 0; b < 5; ++b) *(f32x4*)((float*)(ws + WS_MODP) + ((size_t)(kc * 4 + i) * 5 + b) * 6144 + col) = a[b];
    }
    for (int it = gw; it < 16; it += NGW) {
        const int idx = it * 64 + lane, p = idx >> 4, f = idx & 15;
        const float inv = f == 0 ? 1.000000000e+00f : f == 1 ? 5.623413324e-01f : f == 2 ? 3.162277639e-01f : f == 3 ? 1.778279394e-01f : f == 4 ? 1.000000015e-01f : f == 5 ? 5.623413250e-02f
                        : f == 6 ? 3.162277490e-02f : f == 7 ? 1.778279431e-02f : f == 8 ? 9.999999776e-03f : f == 9 ? 5.623413250e-03f : f == 10 ? 3.162277630e-03f : f == 11 ? 1.778279431e-03f
                        : f == 12 ? 1.000000047e-03f : f == 13 ? 5.623413017e-04f : f == 14 ? 3.162277571e-04f : 1.778279402e-04f;
        const float angf = (float)p * inv; const double xd = (double)angf;
        const double kq = __builtin_rint(xd * 0.63661977236758134308); double rr = __builtin_fma(-kq, 1.57079632679489655800e+00, xd); rr = __builtin_fma(-kq, 6.12323399573676603587e-17, rr);
        const double r2 = rr * rr;
        double sp = -7.6471637318198164759e-13; sp = sp * r2 + 1.6059043836821614599e-10; sp = sp * r2 - 2.5052108385441718775e-08; sp = sp * r2 + 2.7557319223985890653e-06; sp = sp * r2 - 1.9841269841269841270e-04;
        sp = sp * r2 + 8.3333333333333333333e-03; sp = sp * r2 - 1.6666666666666666667e-01; const double sn = rr + rr * r2 * sp;
        double cp = 4.7794773323873852974e-14; cp = cp * r2 - 1.1470745597729724714e-11; cp = cp * r2 + 2.0876756987868098979e-09; cp = cp * r2 - 2.7557319223985890653e-07; cp = cp * r2 + 2.4801587301587301587e-05;
        cp = cp * r2 - 1.3888888888888888889e-03; cp = cp * r2 + 4.1666666666666666667e-02; cp = cp * r2 - 0.5; const double cs = 1.0 + r2 * cp;
        const int qd = (int)kq & 3; const double sv_ = qd == 0 ? sn : qd == 1 ? cs : qd == 2 ? -sn : -cs, cv_ = qd == 0 ? cs : qd == 1 ? -sn : qd == 2 ? -cs : sn;
        ((float*)(ws + WS_TAB))[idx] = (float)cv_; ((float*)(ws + WS_TAB + 4096))[idx] = (float)sv_;
    }
}


template <int MODE>
__device__ __forceinline__ void norm_phase(LAS unsigned char* lds, int tid, int lane, int wave, int G, int nrows,
        const float* srcL, const float* srcC, float* xs_out, const float* ng, const float* modsL, int w, bf16* H,
        const bf16* Y, const int* prow, const float* gprev,
        const float* router, unsigned* cnt, int* tok_e, int* tok_s, float* tok_g) {
    const int rpb = (nrows + G - 1) / G, r0 = (int)blockIdx.x * rpb, r1 = (r0 + rpb < nrows) ? r0 + rpb : nrows;
    LAS float* RT = (LAS float*)lds;
    LAS int* LE = (LAS int*)(lds + 32768); LAS float* LG = (LAS float*)(lds + 32768 + 4096); LAS int* LS = (LAS int*)(lds + 32768 + 8192); LAS int* LBASE = (LAS int*)(lds + 32768 + 12288);
    if (MODE == 1) { for (int i = tid; i < 2048; i += NWAVES * 64) ((LAS f32x4*)RT)[i] = ((const f32x4*)router)[i]; __syncthreads(); }
    int cur_b = -1; f32x4 gsv[4], shv[4], gpv[4];
    for (int r = r0 + wave; r < r1; r += NWAVES) {
        const int bidx = r < TL ? (r >> 12) : 4;
        if (bidx != cur_b) { cur_b = bidx;
#pragma unroll
            for (int j = 0; j < 4; ++j) { const int col = 4 * lane + 256 * j; const f32x4 g = *(const f32x4*)(ng + col), sc = *(const f32x4*)(modsL + bidx * 6144 + (3 * w + 1) * 1024 + col);
                gsv[j] = g * (sc + 1.f); shv[j] = *(const f32x4*)(modsL + bidx * 6144 + (3 * w) * 1024 + col);
                if (MODE == 2) gpv[j] = *(const f32x4*)(gprev + bidx * 6144 + col); } }
        const float* xr = (r < TL) ? srcL + (size_t)r * D : srcC + (size_t)(r - TL) * D;
        f32x4 v[4];
#pragma unroll
        for (int j = 0; j < 4; ++j) v[j] = *(const f32x4*)(xr + 4 * lane + 256 * j);
        if (MODE == 2) { const int p1 = prow[2 * r], p2 = prow[2 * r + 1];
#pragma unroll
            for (int j = 0; j < 4; ++j) { const u32x2 a = *(const u32x2*)(Y + (size_t)p1 * D + 4 * lane + 256 * j), b = *(const u32x2*)(Y + (size_t)p2 * D + 4 * lane + 256 * j);
                const f32x4 ys = (f32x4){bf_lo(a.x) + bf_lo(b.x), bf_hi(a.x) + bf_hi(b.x), bf_lo(a.y) + bf_lo(b.y), bf_hi(a.y) + bf_hi(b.y)};
                v[j] = v[j] + gpv[j] * ys; *(f32x4*)(xs_out + (size_t)r * D + 4 * lane + 256 * j) = v[j]; } }
        float ss = 0.f;
#pragma unroll
        for (int j = 0; j < 4; ++j) ss += (v[j].x * v[j].x + v[j].y * v[j].y) + (v[j].z * v[j].z + v[j].w * v[j].w);
        const float rstd = 1.0f / sqrtf(wave_sum(ss) * (1.f / D) + EPS);
        f32x4 hv[4];
#pragma unroll
        for (int j = 0; j < 4; ++j) { hv[j] = v[j] * rstd * gsv[j] + shv[j];
            u32x2 o; o.x = cvt_pk_bf16(hv[j].x, hv[j].y); o.y = cvt_pk_bf16(hv[j].z, hv[j].w); *(u32x2*)(H + (size_t)r * D + 4 * lane + 256 * j) = o; }
        if (MODE == 1) {
            float lg[8];
#pragma unroll
            for (int e = 0; e < 8; ++e) lg[e] = 0.f;
#pragma unroll
            for (int j = 0; j < 4; ++j)
#pragma unroll
                for (int i = 0; i < 4; ++i) { const LAS f32x4* rp = (const LAS f32x4*)(RT + (4 * lane + 256 * j + i) * 8); const f32x4 ra = rp[0], rb = rp[1]; const float hx = hv[j][i];
                    lg[0] += hx * ra.x; lg[1] += hx * ra.y; lg[2] += hx * ra.z; lg[3] += hx * ra.w; lg[4] += hx * rb.x; lg[5] += hx * rb.y; lg[6] += hx * rb.z; lg[7] += hx * rb.w; }
#pragma unroll
            for (int e = 0; e < 8; ++e) lg[e] = wave_sum(lg[e]);
            float b1 = lg[0]; int i1 = 0;
#pragma unroll
            for (int e = 1; e < 8; ++e) if (lg[e] > b1) { b1 = lg[e]; i1 = e; }
            float b2 = -INFINITY; int i2 = 0;
#pragma unroll
            for (int e = 0; e < 8; ++e) if (e != i1 && lg[e] > b2) { b2 = lg[e]; i2 = e; }
            const float ex = __expf(b2 - b1), g1 = 1.f / (1.f + ex), g2 = ex * g1;
            if (lane == 0) { const int li = 2 * (r - r0); LE[li] = i1; LE[li + 1] = i2; LG[li] = g1; LG[li + 1] = g2; }
        }
    }
    if (MODE == 1) {
        __syncthreads();
        const int n2 = 2 * (r1 - r0 > 0 ? r1 - r0 : 0);
        if (tid < 8) { int n = 0; for (int i = 0; i < n2; ++i) if (LE[i] == tid) { LS[i] = n; ++n; }
            LBASE[tid] = (int)__hip_atomic_fetch_add(cnt + tid, (unsigned)n, __ATOMIC_RELAXED, __HIP_MEMORY_SCOPE_AGENT); }
        __syncthreads();
        for (int i = tid; i < n2; i += NWAVES * 64) { const int e = LE[i]; tok_e[2 * r0 + i] = e; tok_s[2 * r0 + i] = LBASE[e] + LS[i]; tok_g[2 * r0 + i] = LG[i]; }
        __syncthreads();
    }
}

struct MoeLayout { int tp[9]; };
__device__ __forceinline__ MoeLayout moe_layout(const unsigned* cnt) {
    MoeLayout L; L.tp[0] = 0;
#pragma unroll
    for (int e = 0; e < 8; ++e) { const unsigned c = __hip_atomic_load(cnt + e, __ATOMIC_RELAXED, __HIP_MEMORY_SCOPE_AGENT); L.tp[e + 1] = L.tp[e] + (int)((c + 255u) >> 8); }
    return L;
}
__device__ __forceinline__ void permute_phase(int lane, int wave, int G, const unsigned* cnt, const int* tok_e, const int* tok_s, const float* tok_g, const bf16* H, bf16* AS, float* gwv, int* prow) {
    const MoeLayout L = moe_layout(cnt);
    const int gw = (int)blockIdx.x * NWAVES + wave, NGW = G * NWAVES;
    for (int t = gw; t < TL; t += NGW) {
        const u32x4 a = *(const u32x4*)(H + (size_t)t * D + lane * 8), b = *(const u32x4*)(H + (size_t)t * D + 512 + lane * 8);
#pragma unroll
        for (int j = 0; j < 2; ++j) { const int e = tok_e[2 * t + j], s = tok_s[2 * t + j]; int base = 0;
#pragma unroll
            for (int k = 1; k < 8; ++k) base = (e == k) ? L.tp[k] : base;
            const int row = base * 256 + s;
            *(u32x4*)(AS + (size_t)row * D + lane * 8) = a; *(u32x4*)(AS + (size_t)row * D + 512 + lane * 8) = b;
            if (lane == 0) { gwv[row] = tok_g[2 * t + j]; prow[2 * t + j] = row; } }
    }
}
__device__ __forceinline__ void final_phase(int lane, int wave, int G, const float* XS, const bf16* Y, const int* prow, const float* gprev, float* out) {
    const int gw = (int)blockIdx.x * NWAVES + wave, NGW = G * NWAVES;
    for (int r = gw; r < TL; r += NGW) { const int bidx = r >> 12; const int p1 = prow[2 * r], p2 = prow[2 * r + 1];
#pragma unroll
        for (int j = 0; j < 4; ++j) { const int col = 4 * lane + 256 * j; const u32x2 a = *(const u32x2*)(Y + (size_t)p1 * D + col), b = *(const u32x2*)(Y + (size_t)p2 * D + col);
            const f32x4 ys = (f32x4){bf_lo(a.x) + bf_lo(b.x), bf_hi(a.x) + bf_hi(b.x), bf_lo(a.y) + bf_lo(b.y), bf_hi(a.y) + bf_hi(b.y)};
            *(f32x4*)(out + (size_t)r * D + col) = *(const f32x4*)(XS + (size_t)r * D + col) + *(const f32x4*)(gprev + bidx * 6144 + col) * ys; } }
}
__device__ __forceinline__ void copy_phase(int lane, int wave, int G, const float* XS, float* out) {
    const int gw = (int)blockIdx.x * NWAVES + wave, NGW = G * NWAVES;
    for (int r = gw; r < TL; r += NGW)
#pragma unroll
        for (int j = 0; j < 4; ++j) { const int col = 4 * lane + 256 * j; *(f32x4*)(out + (size_t)r * D + col) = *(const f32x4*)(XS + (size_t)r * D + col); }
}

typedef short v4i16_t __attribute__((ext_vector_type(4)));
__device__ __forceinline__ void sgu_phase(LAS unsigned char* lds, int tid, int nchunks, const bf16* Z, const float* rowss, const float* wsp, const float* bsp, const float* vg, bf16* GT) {
    const int lane = tid & 63, wave = __builtin_amdgcn_readfirstlane(tid >> 6), fr = lane & 15, fq = lane >> 4;
    LAS float* RS = (LAS float*)lds; LAS unsigned char* WL = lds + 1024; LAS unsigned char* VL = lds + 1024 + 128 * 272;
    const int nunits = nchunks * 8;
    for (int un = (int)blockIdx.x; un < nunits; un += (int)gridDim.x) {
        const int ch = un >> 3, g = un & 7, rbase = ch * 128;
        if (tid < 128) { const f32x4* rp = (const f32x4*)(rowss + (size_t)(rbase + tid) * 32); float ssum = 0.f;
#pragma unroll
            for (int q = 0; q < 8; ++q) { const f32x4 pv = rp[q]; ssum += (pv.x + pv.y) + (pv.z + pv.w); }
            RS[tid] = 1.0f / sqrtf(ssum * (1.f / ADIM) + EPS); }
        __syncthreads();
#pragma unroll
        for (int k = 0; k < 8; ++k) { const int idx = tid + 512 * k, t = idx >> 5, s = (idx & 31) * 4;
            const f32x4 wv = *(const f32x4*)(wsp + (size_t)g * 16384 + t * 128 + s) * *(const LAS f32x4*)(RS + s);
            u32x2 o; o.x = cvt_pk_bf16(wv.x, wv.y); o.y = cvt_pk_bf16(wv.z, wv.w); *(LAS u32x2*)(WL + t * 272 + s * 2) = o; }
#pragma unroll
        for (int k = 0; k < 8; ++k) { const int idx = tid + 512 * k, sr = idx >> 5, c = idx & 31;
            *(LAS u32x4*)(VL + sr * 528 + c * 16) = *(const u32x4*)(Z + (size_t)(rbase + sr) * 4096 + ADIM + g * 256 + c * 8); }
        __syncthreads();
        f32x4 acc[2][8];
#pragma unroll
        for (int mb = 0; mb < 2; ++mb)
#pragma unroll
            for (int nb = 0; nb < 8; ++nb) acc[mb][nb] = (f32x4){0.f, 0.f, 0.f, 0.f};
#pragma unroll
        for (int ks = 0; ks < 4; ++ks) {
            bf16x8 a[2];
#pragma unroll
            for (int mb = 0; mb < 2; ++mb) { LAS unsigned char* p = VL + (32 * ks + 8 * fq + (fr >> 2)) * 528 + (32 * wave + 16 * mb + 4 * (fr & 3)) * 2;
                const v4i16_t lo = __builtin_amdgcn_ds_read_tr16_b64_v4i16((LAS v4i16_t*)p), hi = __builtin_amdgcn_ds_read_tr16_b64_v4i16((LAS v4i16_t*)(p + 4 * 528));
                a[mb] = (bf16x8){lo[0], lo[1], lo[2], lo[3], hi[0], hi[1], hi[2], hi[3]}; }
#pragma unroll
            for (int nb = 0; nb < 8; ++nb) { const bf16x8 b = *(const LAS bf16x8*)(WL + (16 * nb + fr) * 272 + (32 * ks + 8 * fq) * 2);
#pragma unroll
                for (int mb = 0; mb < 2; ++mb) acc[mb][nb] = __builtin_amdgcn_mfma_f32_16x16x32_bf16(a[mb], b, acc[mb][nb], 0, 0, 0); }
        }
#pragma unroll
        for (int mb = 0; mb < 2; ++mb) { const int dcol = g * 256 + 32 * wave + 16 * mb + 4 * fq; const f32x4 vgv = *(const f32x4*)(vg + dcol);
#pragma unroll
            for (int nb = 0; nb < 8; ++nb) { const int t = 16 * nb + fr; const size_t row = (size_t)(rbase + t); const float bsv = bsp[g * 128 + t];
                const u32x2 uu = *(const u32x2*)(Z + row * 4096 + dcol); const f32x4 mx = acc[mb][nb] * vgv + bsv;
                u32x2 o; o.x = cvt_pk_bf16(bf_lo(uu.x) * mx.x, bf_hi(uu.x) * mx.y); o.y = cvt_pk_bf16(bf_lo(uu.y) * mx.z, bf_hi(uu.y) * mx.w);
                *(u32x2*)(GT + row * ADIM + dcol) = o; } }
        __syncthreads();
    }
}

__device__ __forceinline__ void pool_phase(int tid, int G, const bf16* H, bf16* PB) {
    const int chunk = tid & 127, rs = tid >> 7, c0 = chunk * 8, half = 1 << (c0 >> 8);
    for (int un = (int)blockIdx.x; un < TL / 32; un += G) {
        for (int rr = 0; rr < 8; ++rr) { const int row = un * 32 + rs * 8 + rr, tb = row & (SEQ - 1), bb = row - tb;
            const int lo = tb - half > 0 ? tb - half : 0, hi = tb + half - 1 < SEQ - 1 ? tb + half - 1 : SEQ - 1;
            float s[8];
#pragma unroll
            for (int i = 0; i < 8; ++i) s[i] = 0.f;
            for (int q = lo; q <= hi; ++q) { const u32x4 v = *(const u32x4*)(H + (size_t)(bb + q) * D + c0);
                s[0] += bf_lo(v.x); s[1] += bf_hi(v.x); s[2] += bf_lo(v.y); s[3] += bf_hi(v.y); s[4] += bf_lo(v.z); s[5] += bf_hi(v.z); s[6] += bf_lo(v.w); s[7] += bf_hi(v.w); }
            const u32x4 o = *(const u32x4*)(H + (size_t)row * D + c0); const float inv = 1.f / (float)(hi - lo + 1);
            u32x4 w; w.x = cvt_pk_bf16(s[0] * inv - bf_lo(o.x), s[1] * inv - bf_hi(o.x)); w.y = cvt_pk_bf16(s[2] * inv - bf_lo(o.y), s[3] * inv - bf_hi(o.y));
            w.z = cvt_pk_bf16(s[4] * inv - bf_lo(o.z), s[5] * inv - bf_hi(o.z)); w.w = cvt_pk_bf16(s[6] * inv - bf_lo(o.w), s[7] * inv - bf_hi(o.w));
            *(u32x4*)(PB + (size_t)row * D + c0) = w; }
    }
}

struct Args { const float* in[25]; float* out; unsigned char* ws; int ph_lo, ph_hi; };
#define CAS __attribute__((address_space(4)))
__device__ __forceinline__ const CAS char* karg_base() { const CAS char* p = (const CAS char*)__builtin_amdgcn_kernarg_segment_ptr(); asm volatile("" : "+s"(p)); return p; }
__device__ __forceinline__ const float* karg_in(int k) { return *(const float* const CAS*)(karg_base() + 8 * k); }
__device__ __forceinline__ float* karg_out() { return *(float* const CAS*)(karg_base() + 200); }
__device__ __forceinline__ unsigned char* karg_ws() { return *(unsigned char* const CAS*)(karg_base() + 208); }
#define WSB(T, off) ((T*)(karg_ws() + (off)))
#define MODS(layer, which) (WSB(float, WS_MODS) + (layer) * 5 * 6144 + (which) * 1024)
#define XS_ WSB(float, WS_XS)
#define H_ WSB(bf16, WS_H)
#define CNT(l) ((unsigned*)(WSB(unsigned, WS_CTL) + CW_CNT + 64 * (l)))
#define NORM_G(i, w) (karg_in(6) + ((i) * 2 + (w)) * 1024)
__global__ void __launch_bounds__(NWAVES * 64, 2) trunk_fwd(Args args) {
    extern __shared__ __attribute__((aligned(16))) unsigned char lds_raw[];
    LAS unsigned char* const lds = (LAS unsigned char*)lds_raw;
    volatile LAS unsigned* const MISC = (volatile LAS unsigned*)(lds + MISC_OFF);
    const int wave = __builtin_amdgcn_readfirstlane((int)threadIdx.x >> 6), G = gridDim.x, bx = blockIdx.x;
#define lane ((int)__builtin_amdgcn_mbcnt_hi(~0u, __builtin_amdgcn_mbcnt_lo(~0u, 0u)))
#define tid (wave * 64 + lane)
    const int vcu = (G % 8 == 0) ? (bx % 8) * (G / 8) + bx / 8 : bx;
    static_assert(offsetof(Args, out) == 200 && offsetof(Args, ws) == 208, "kernarg layout");

    for (int u = (int)threadIdx.x; u < (LDS_BYTES - LDSCTL_OFF) / 4; u += NWAVES * 64) ((LAS unsigned*)(lds + LDSCTL_OFF))[u] = 0u;
    __syncthreads();
    XcdBarrier bar; bar.bar = WSB(unsigned, WS_CTL) + CW_BAR; bar.x = 0; bar.st = nullptr;
    if (!MK_PER_PHASE) bar = xcd_barrier_post(WSB(unsigned, WS_CTL) + CW_BAR, MISC + 8, tid);
#define GRID_BAR() do { if (MK_PER_PHASE) { if (tid == 0) __hip_atomic_store((gu32*)WSB(unsigned, WS_CTL) + CW_TMO, 0xBADBA0u, RLX_AGENT); } else { xcd_barrier(bar, tid); } } while (0)
    const int lo = args.ph_lo, hi = args.ph_hi;
#define IN(k) (lo <= (k) && (k) < hi && (k) <= DBG_STOP)
#define SEAM(k) do { if (IN(k) && IN((k) + 1)) GRID_BAR(); } while (0)
#define GEMM_PHASE(EPI, ORD, nM, nN, gm, ep) do { pg8::ORD S_; S_.init((nM), (nN), G, bx); pg8::gemm_phase<pg8::EPI, pg8::ORD, true>(lds + RING_OFF, tid, gm, S_, ep); } while (0)
#define MOE_PHASE(EPI, l, nN, gm, ep) do { const MoeLayout L_ = moe_layout(CNT(l)); pg8::MoeOrder S_; S_.init(L_.tp[8], (nN), G, bx); _Pragma("unroll") for (int k_ = 0; k_ < 8; ++k_) S_.tp[k_] = L_.tp[k_]; \
        pg8::gemm_phase<pg8::EPI, pg8::MoeOrder, true>(lds + RING_OFF, tid, gm, S_, ep); } while (0)
#define NORM0(nrows, srcL, srcC, layer, w) norm_phase<0>(lds, tid, lane, wave, G, nrows, srcL, srcC, nullptr, NORM_G(layer, w), MODS(layer, 0), w, H_, nullptr, nullptr, nullptr, nullptr, nullptr, nullptr, nullptr, nullptr)

    if (IN(0)) { p0_adaln(karg_in(1), karg_in(3), karg_in(4), karg_ws(), lane, wave, G); } SEAM(0);
    if (IN(1)) { In I; I.x = karg_in(0); I.c = karg_in(1); I.ctx = karg_in(2); I.c_ctx = karg_in(3); I.ada_w = karg_in(4); I.ada_b = karg_in(5); I.norm_g = karg_in(6); I.a_w_in = karg_in(7); I.a_v_g = karg_in(8);
        I.a_ws = karg_in(9); I.a_bs = karg_in(10); I.a_w_out = karg_in(11); I.b_w_qkv = karg_in(12); I.b_q_g = karg_in(13); I.b_k_g = karg_in(14); I.b_w_o = karg_in(15); I.p_w = karg_in(16); I.p_scale = karg_in(17);
        I.f_w_gate = karg_in(18); I.f_w_up = karg_in(19); I.f_w_down = karg_in(20); I.m_router = karg_in(21); I.m_w_gate = karg_in(22); I.m_w_up = karg_in(23); I.m_w_down = karg_in(24);
        p1_convert(I, karg_ws(), lds, lane, wave, G); } SEAM(1);
    if (IN(2)) { NORM0(TT, karg_in(0), karg_in(2), 0, 0); } SEAM(2);
    if (IN(3)) { pg8::Gemm g{H_, WSB(const bf16, W_IN), D, D, 0, 0}; pg8::EpiGelu E{WSB(bf16, WS_BIG), WSB(float, WS_RSP)}; GEMM_PHASE(EpiGelu, StaticOrder, TT / 256, 16, g, E); } SEAM(3);
    if (IN(4)) { sgu_phase(lds, tid, TT / 128, WSB(const bf16, WS_BIG), WSB(const float, WS_RSP), karg_in(9), karg_in(10), karg_in(8), WSB(bf16, WS_R2)); } SEAM(4);
    if (IN(5)) { pg8::Gemm g{WSB(const bf16, WS_R2), WSB(const bf16, W_OUT), ADIM, ADIM, 0, 0}; pg8::EpiResid E{karg_in(0), karg_in(2), XS_, MODS(0, 2), nullptr}; GEMM_PHASE(EpiResid, StaticOrder, TT / 256, 4, g, E); } SEAM(5);
    if (IN(6)) { NORM0(TT, XS_, XS_ + (size_t)TL * D, 0, 1); } SEAM(6);
    if (IN(7)) { pg8::Gemm g{H_, WSB(const bf16, W_GU), D, D, 0, 0}; pg8::EpiSwiGLU E{WSB(bf16, WS_BIG), FF}; GEMM_PHASE(EpiSwiGLU, StaticOrder, TT / 256, 2 * FF / 256, g, E); } SEAM(7);
    if (IN(8)) { pg8::Gemm g{WSB(const bf16, WS_BIG), WSB(const bf16, W_DN), FF, FF, 0, 0}; float* xs = XS_; pg8::EpiResid E{xs, xs + (size_t)TL * D, xs, MODS(0, 5), nullptr}; GEMM_PHASE(EpiResid, StaticOrder, TT / 256, 4, g, E); } SEAM(8);
    if (IN(9)) { NORM0(TT, XS_, XS_ + (size_t)TL * D, 1, 0); } SEAM(9);
    if (IN(10)) { pg8::Gemm g{H_, WSB(const bf16, W_QKV), D, D, 0, 0};
        pg8::EpiQKV E{WSB(bf16, WS_BIG), WSB(bf16, WS_BIG + 64 * MiB), WSB(bf16, WS_BIG + 73 * MiB), karg_in(13), karg_in(14), WSB(const float, WS_TAB), WSB(const float, WS_TAB + 4096), attn_body::C2};
        GEMM_PHASE(EpiQKV, StaticOrder, TT / 256, QKVW / 256, g, E); } SEAM(10);
    if (IN(11)) { const attn_body::AttnTensors AT{WSB(const attn_body::bf16, WS_BIG), WSB(const attn_body::bf16, WS_BIG + 64 * MiB), WSB(const attn_body::bf16, WS_BIG + 73 * MiB), WSB(attn_body::bf16, WS_BIG + 32 * MiB)};
        const attn_body::StaticOrder S(G, vcu); attn_body::attn_phase<attn_body::StaticOrder>(tid, (char*)lds_raw + RING_OFF, AT, S); } SEAM(11);
    if (IN(12)) { pg8::Gemm g{WSB(const bf16, WS_BIG + 32 * MiB), WSB(const bf16, W_O), D, D, 0, 0}; float* xs = XS_; pg8::EpiResid E{xs, xs + (size_t)TL * D, xs, MODS(1, 2), nullptr}; GEMM_PHASE(EpiResid, StaticOrder, TL / 256, 4, g, E); } SEAM(12);
    if (IN(13)) { norm_phase<1>(lds, tid, lane, wave, G, TL, XS_, XS_ + (size_t)TL * D, nullptr, NORM_G(1, 1), MODS(1, 0), 1, H_, nullptr, nullptr, nullptr, karg_in(21), CNT(0), WSB(int, WS_TOKE), WSB(int, WS_TOKS), WSB(float, WS_TOKG)); } SEAM(13);
    if (IN(14)) { permute_phase(lane, wave, G, CNT(0), WSB(const int, WS_TOKE), WSB(const int, WS_TOKS), WSB(const float, WS_TOKG), H_, WSB(bf16, WS_R2), WSB(float, WS_GW), WSB(int, WS_PROW)); } SEAM(14);
    if (IN(15)) { pg8::Gemm g{WSB(const bf16, WS_R2), WSB(const bf16, M_GU), D, D, 0, (size_t)2 * ED * D}; pg8::EpiSwiGLU E{WSB(bf16, WS_BIG), ED}; MOE_PHASE(EpiSwiGLU, 0, 2 * ED / 256, g, E); } SEAM(15);
    if (IN(16)) { pg8::Gemm g{WSB(const bf16, WS_BIG), WSB(const bf16, M_DN), ED, ED, 0, (size_t)D * ED}; pg8::EpiMoeDown E{WSB(bf16, WS_R2), WSB(const float, WS_GW)}; MOE_PHASE(EpiMoeDown, 0, 4, g, E); } SEAM(16);
    if (IN(17)) { float* xs = XS_; norm_phase<2>(lds, tid, lane, wave, G, TL, xs, xs + (size_t)TL * D, xs, NORM_G(2, 0), MODS(2, 0), 0, H_, WSB(const bf16, WS_R2), WSB(const int, WS_PROW), MODS(1, 5), nullptr, nullptr, nullptr, nullptr, nullptr); } SEAM(17);
    if (IN(18)) { pool_phase(tid, G, H_, WSB(bf16, WS_BIG)); } SEAM(18);
    if (IN(19)) { pg8::Gemm g{WSB(const bf16, WS_BIG), WSB(const bf16, W_P), 256, D, 256, 0}; float* xs = XS_; pg8::EpiResid E{xs, xs + (size_t)TL * D, xs, MODS(2, 2), karg_in(17)}; GEMM_PHASE(EpiResid, StaticOrder, TL / 256, 4, g, E); } SEAM(19);
    if (IN(20)) { NORM0(TL, XS_, XS_ + (size_t)TL * D, 2, 1); } SEAM(20);
    if (IN(21)) { pg8::Gemm g{H_, WSB(const bf16, W_GU) + (size_t)2 * FF * D, D, D, 0, 0}; pg8::EpiSwiGLU E{WSB(bf16, WS_BIG), FF}; GEMM_PHASE(EpiSwiGLU, StaticOrder, TL / 256, 2 * FF / 256, g, E); } SEAM(21);
    if (IN(22)) { pg8::Gemm g{WSB(const bf16, WS_BIG), WSB(const bf16, W_DN) + (size_t)D * FF, FF, FF, 0, 0}; float* xs = XS_; pg8::EpiResid E{xs, xs + (size_t)TL * D, xs, MODS(2, 5), nullptr}; GEMM_PHASE(EpiResid, StaticOrder, TL / 256, 4, g, E); } SEAM(22);
    if (IN(23)) { NORM0(TL, XS_, XS_ + (size_t)TL * D, 3, 0); } SEAM(23);
    if (IN(24)) { pg8::Gemm g{H_, WSB(const bf16, W_IN) + (size_t)4096 * D, D, D, 0, 0}; pg8::EpiGelu E{WSB(bf16, WS_BIG), WSB(float, WS_RSP)}; GEMM_PHASE(EpiGelu, StaticOrder, TL / 256, 16, g, E); } SEAM(24);
    if (IN(25)) { sgu_phase(lds, tid, TL / 128, WSB(const bf16, WS_BIG), WSB(const float, WS_RSP), karg_in(9) + 8 * 16384, karg_in(10) + 8 * 128, karg_in(8) + ADIM, WSB(bf16, WS_R2)); } SEAM(25);
    if (IN(26)) { pg8::Gemm g{WSB(const bf16, WS_R2), WSB(const bf16, W_OUT) + (size_t)D * ADIM, ADIM, ADIM, 0, 0}; float* xs = XS_; pg8::EpiResid E{xs, xs + (size_t)TL * D, xs, MODS(3, 2), nullptr}; GEMM_PHASE(EpiResid, StaticOrder, TL / 256, 4, g, E); } SEAM(26);
    if (IN(27)) { norm_phase<1>(lds, tid, lane, wave, G, TL, XS_, XS_ + (size_t)TL * D, nullptr, NORM_G(3, 1), MODS(3, 0), 1, H_, nullptr, nullptr, nullptr, karg_in(21) + 8192, CNT(1), WSB(int, WS_TOKE), WSB(int, WS_TOKS), WSB(float, WS_TOKG)); } SEAM(27);
    if (IN(28)) { permute_phase(lane, wave, G, CNT(1), WSB(const int, WS_TOKE), WSB(const int, WS_TOKS), WSB(const float, WS_TOKG), H_, WSB(bf16, WS_R2), WSB(float, WS_GW), WSB(int, WS_PROW)); } SEAM(28);
    if (IN(29)) { pg8::Gemm g{WSB(const bf16, WS_R2), WSB(const bf16, M_GU) + (size_t)8 * 2 * ED * D, D, D, 0, (size_t)2 * ED * D}; pg8::EpiSwiGLU E{WSB(bf16, WS_BIG), ED}; MOE_PHASE(EpiSwiGLU, 1, 2 * ED / 256, g, E); } SEAM(29);
    if (IN(30)) { pg8::Gemm g{WSB(const bf16, WS_BIG), WSB(const bf16, M_DN) + (size_t)8 * D * ED, ED, ED, 0, (size_t)D * ED}; pg8::EpiMoeDown E{WSB(bf16, WS_R2), WSB(const float, WS_GW)}; MOE_PHASE(EpiMoeDown, 1, 4, g, E); } SEAM(30);
    if (IN(31)) { final_phase(lane, wave, G, XS_, WSB(const bf16, WS_R2), WSB(const int, WS_PROW), MODS(3, 5), karg_out()); }
    if (DBG_STOP < 31 && (MK_PER_PHASE ? (lo == DBG_STOP + 1) : true)) {
        if (!MK_PER_PHASE) GRID_BAR();
        copy_phase(lane, wave, G, XS_, karg_out());
    }
#undef IN
#undef SEAM
#undef lane
#undef tid
}

extern "C" void kernel_launch(void* const* d_in, const int* in_sizes, int n_in, void* d_out, int out_size, void* d_ws, size_t ws_size, hipStream_t stream) {
    static int grid = 0;
    if (grid == 0) {
        if (n_in != 25 || out_size != TL * D || ws_size < WS_END) { fprintf(stderr, "kernel_launch: unexpected problem: n_in %d out %d ws %zu (need %zu)\n", n_in, out_size, ws_size, (size_t)WS_END); grid = -1; return; }
        int dev = 0, cus = 0, per_cu = 0;
        if (hipGetDevice(&dev) != hipSuccess || hipDeviceGetAttribute(&cus, hipDeviceAttributeMultiprocessorCount, dev) != hipSuccess) { grid = -1; return; }
        if (hipFuncSetAttribute((const void*)trunk_fwd, hipFuncAttributeMaxDynamicSharedMemorySize, LDS_BYTES) != hipSuccess) { fprintf(stderr, "kernel_launch: hipFuncSetAttribute failed\n"); grid = -1; return; }
        if (hipOccupancyMaxActiveBlocksPerMultiprocessor(&per_cu, (const void*)trunk_fwd, NWAVES * 64, LDS_BYTES) != hipSuccess || per_cu < 1) fprintf(stderr, "kernel_launch: occupancy query reports %d\n", per_cu);
        (void)hipGetLastError();
        grid = cus;
    }
    if (grid < 0) return;
    if (hipMemsetAsync((char*)d_ws + WS_CTL, 0, CTL_ZERO_BYTES, stream) != hipSuccess) return;
    Args a{};
    for (int i = 0; i < 25; ++i) a.in[i] = (const float*)d_in[i];
    a.out = (float*)d_out; a.ws = (unsigned char*)d_ws;
    if (MK_PER_PHASE) {
        for (int k = 0; k < NPH; ++k) { if (k > DBG_STOP + 1) break; a.ph_lo = k; a.ph_hi = k + 1; hipLaunchKernelGGL(trunk_fwd, dim3(grid), dim3(NWAVES * 64), LDS_BYTES, stream, a); }
    } else { a.ph_lo = 0; a.ph_hi = NPH; hipLaunchKernelGGL(trunk_fwd, dim3(grid), dim3(NWAVES * 64), LDS_BYTES, stream, a); }
}
```

```cpp
#include <hip/hip_runtime.h>
#include <hip/hip_bf16.h>
#include <cstdio>
#include <cstdint>
#include <cmath>

namespace pg8 {
#define PG8_LAS __attribute__((address_space(3)))
typedef unsigned short bf16_t;
typedef short bf16x8 __attribute__((ext_vector_type(8)));
typedef float f32x4 __attribute__((ext_vector_type(4)));
typedef float f32x2 __attribute__((ext_vector_type(2)));
typedef unsigned u32x4 __attribute__((ext_vector_type(4)));
typedef unsigned u32x2 __attribute__((ext_vector_type(2)));
constexpr int BM = 256, BK = 64, HALF = 128, HTB = HALF * BK * 2  , STAGE_BYTES = 8 * HTB, NXCD = 8, WGM = 8;

__host__ __device__ __forceinline__ int lds_byte(int r, int c) { const int st = (r >> 4) * 2 + (c >> 5), rr = r & 15, cc = c & 31, ob = rr * 64 + cc * 2; return st * 1024 + (ob ^ (((ob >> 9) & 1) << 5)); }
__host__ __device__ __forceinline__ void stage_rc(int b, int& R, int& C) { const int st = b / 1024, sb = b % 1024, swz = sb ^ (((sb >> 9) & 1) << 5); R = (st >> 1) * 16 + swz / 64; C = (st & 1) * 32 + (swz % 64) / 2; }
__host__ __device__ __forceinline__ int perm32(int rho) { const int n = rho >> 4, i = rho & 15; return 8 * (i >> 2) + 4 * n + (i & 3); }

struct Unit { int pm, pn, e; };
struct Gemm { const bf16_t* A; const bf16_t* Bt; int K; int lda; int a_pn_stride; size_t b_e_stride; };

struct StaticOrder {
    int nM, nN, nwg, G, c;
    __device__ void init(int nM_, int nN_, int G_, int c_) { nM = nM_; nN = nN_; nwg = nM * nN; G = G_; c = c_; }
    __device__ bool next(int i, Unit& u) const {
        const long L = (long)i * G + c; if (L >= nwg) return false;
        int wgid = (int)L; { const int q = nwg / NXCD, r = nwg % NXCD, xcd = wgid % NXCD, off = wgid / NXCD; wgid = (xcd < r ? xcd * (q + 1) : r * (q + 1) + (xcd - r) * q) + off; }
        const int nig = WGM * nN, gid = wgid / nig, fm = gid * WGM, gsz = (nM - fm) < WGM ? (nM - fm) : WGM;
        u.pm = fm + ((wgid % nig) % gsz); u.pn = (wgid % nig) / gsz; u.e = 0; return true;
    }
};
struct MoeOrder : StaticOrder {
    int tp[8];
    __device__ bool next(int i, Unit& u) const {
        if (!StaticOrder::next(i, u)) return false;
        int e = 0;
#pragma unroll
        for (int k = 1; k < 8; ++k) e += (u.pm >= tp[k]) ? 1 : 0;
        u.e = e; return true;
    }
};

__device__ __forceinline__ unsigned cvt_pk_bf16(float lo, float hi) { unsigned r; asm volatile("v_cvt_pk_bf16_f32 %0, %1, %2" : "=v"(r) : "v"(lo), "v"(hi)); return r; }
__device__ __forceinline__ unsigned pk4_fp8(float a, float b, float c, float d) {
    a = __builtin_fminf(__builtin_fmaxf(a, -448.f), 448.f); b = __builtin_fminf(__builtin_fmaxf(b, -448.f), 448.f); c = __builtin_fminf(__builtin_fmaxf(c, -448.f), 448.f); d = __builtin_fminf(__builtin_fmaxf(d, -448.f), 448.f);
    int w = 0; w = __builtin_amdgcn_cvt_pk_fp8_f32(a, b, w, false); w = __builtin_amdgcn_cvt_pk_fp8_f32(c, d, w, true); return (unsigned)w; }
__device__ __forceinline__ float bf_lo(unsigned w) { return __builtin_bit_cast(float, w << 16); }
__device__ __forceinline__ float bf_hi(unsigned w) { return __builtin_bit_cast(float, w & 0xffff0000u); }
__device__ __forceinline__ float sigmoidf_(float x) { return __builtin_amdgcn_rcpf(1.f + __builtin_amdgcn_exp2f(-1.4426950408889634f * x)); }
__device__ __forceinline__ float gelu_tanh(float x) { const float y = 1.5957691216057308f * x * (1.f + 0.044715f * x * x); return x * sigmoidf_(y); }

typedef f32x4 AccT[2][2][4][2];

struct EpiGelu {
    static constexpr bool PERM = true;
    bf16_t* Z; float* rowss;
    __device__ __forceinline__ void operator()(const AccT& acc, const Unit& u, int wr, int wc, int fr, int fq) const {
        const int row0 = u.pm * BM + wr * 64 + fr, col0 = u.pn * BM + wc * 32 + 8 * fq; const bool isv = u.pn >= 8;
#pragma unroll
        for (int ai = 0; ai < 2; ++ai)
#pragma unroll
            for (int m = 0; m < 4; ++m) { const int row = row0 + ai * HALF + m * 16; bf16_t* rowp = Z + (size_t)row * 4096 + col0; float ss = 0.f;
#pragma unroll
                for (int bj = 0; bj < 2; ++bj) { f32x4 v0 = acc[ai][bj][m][0], v1 = acc[ai][bj][m][1];
#pragma unroll
                    for (int j = 0; j < 4; ++j) { v0[j] = gelu_tanh(v0[j]); v1[j] = gelu_tanh(v1[j]); ss += v0[j] * v0[j] + v1[j] * v1[j]; }
                    u32x4 w; w.x = cvt_pk_bf16(v0[0], v0[1]); w.y = cvt_pk_bf16(v0[2], v0[3]); w.z = cvt_pk_bf16(v1[0], v1[1]); w.w = cvt_pk_bf16(v1[2], v1[3]);
                    *(u32x4*)(rowp + bj * HALF) = w; }
                if (isv) { ss += __shfl_xor(ss, 16); ss += __shfl_xor(ss, 32); if (fq == 0) rowss[(size_t)row * 32 + (u.pn - 8) * 4 + wc] = ss; } }
    }
};
struct EpiResid {
    static constexpr bool PERM = false;
    const float* base_l; const float* base_c; float* out; const float* gate; const float* cscale;
    __device__ __forceinline__ void operator()(const AccT& acc, const Unit& u, int wr, int wc, int fr, int fq) const {
        const int row0 = u.pm * BM + wr * 64 + fr, col0 = u.pn * BM + wc * 32 + 4 * fq; const bool lat = u.pm < 64; const int bidx = lat ? (u.pm >> 4) : 4;
        f32x4 gv[2][2];
#pragma unroll
        for (int bj = 0; bj < 2; ++bj)
#pragma unroll
            for (int n = 0; n < 2; ++n) { gv[bj][n] = *(const f32x4*)(gate + bidx * 6144 + col0 + bj * HALF + n * 16); if (cscale) gv[bj][n] = gv[bj][n] * *(const f32x4*)(cscale + col0 + bj * HALF + n * 16); }
#pragma unroll
        for (int ai = 0; ai < 2; ++ai)
#pragma unroll
            for (int m = 0; m < 4; ++m) { const int row = row0 + ai * HALF + m * 16;
                const float* bp = (lat ? base_l + (size_t)row * 1024 : base_c + (size_t)(row - 16384) * 1024) + col0; float* op = out + (size_t)row * 1024 + col0;
#pragma unroll
                for (int bj = 0; bj < 2; ++bj)
#pragma unroll
                    for (int n = 0; n < 2; ++n) { const f32x4 o = *(const f32x4*)(bp + bj * HALF + n * 16) + gv[bj][n] * acc[ai][bj][m][n]; *(f32x4*)(op + bj * HALF + n * 16) = o; }
                if (m & 1) asm volatile("" ::: "memory"); }
    }
};
struct EpiSwiGLU {
    static constexpr bool PERM = true;
    bf16_t* Hd; int ldh;
    __device__ __forceinline__ void operator()(const AccT& acc, const Unit& u, int wr, int wc, int fr, int fq) const {
        const int row0 = u.pm * BM + wr * 64 + fr, col0 = u.pn * HALF + wc * 32 + 8 * fq;
#pragma unroll
        for (int ai = 0; ai < 2; ++ai)
#pragma unroll
            for (int m = 0; m < 4; ++m) { const int row = row0 + ai * HALF + m * 16; float o[8];
#pragma unroll
                for (int n = 0; n < 2; ++n)
#pragma unroll
                    for (int j = 0; j < 4; ++j) { const float gt = acc[ai][0][m][n][j], up = acc[ai][1][m][n][j]; o[4 * n + j] = gt * sigmoidf_(gt) * up; }
                u32x4 w; w.x = cvt_pk_bf16(o[0], o[1]); w.y = cvt_pk_bf16(o[2], o[3]); w.z = cvt_pk_bf16(o[4], o[5]); w.w = cvt_pk_bf16(o[6], o[7]);
                *(u32x4*)(Hd + (size_t)row * ldh + col0) = w; }
    }
};
struct EpiSwiGLU8 {
    static constexpr bool PERM = true;
    unsigned char* Hd; int ldh; float inscale, outscale;
    __device__ __forceinline__ void operator()(const AccT& acc, const Unit& u, int wr, int wc, int fr, int fq) const {
        const int row0 = u.pm * BM + wr * 64 + fr, col0 = u.pn * HALF + wc * 32 + 8 * fq;
#pragma unroll
        for (int ai = 0; ai < 2; ++ai)
#pragma unroll
            for (int m = 0; m < 4; ++m) { const int row = row0 + ai * HALF + m * 16; float o[8];
#pragma unroll
                for (int n = 0; n < 2; ++n)
#pragma unroll
                    for (int j = 0; j < 4; ++j) { const float gt = acc[ai][0][m][n][j] * inscale, up = acc[ai][1][m][n][j] * inscale; o[4 * n + j] = gt * sigmoidf_(gt) * up * outscale; }
                u32x2 w; w.x = pk4_fp8(o[0], o[1], o[2], o[3]); w.y = pk4_fp8(o[4], o[5], o[6], o[7]);
                *(u32x2*)(Hd + (size_t)row * ldh + col0) = w; }
    }
};
struct EpiMoeDown {
    static constexpr bool PERM = true;
    bf16_t* Y; const float* gw; float inscale;
    __device__ __forceinline__ void operator()(const AccT& acc, const Unit& u, int wr, int wc, int fr, int fq) const {
        const int row0 = u.pm * BM + wr * 64 + fr, col0 = u.pn * BM + wc * 32 + 8 * fq;
#pragma unroll
        for (int ai = 0; ai < 2; ++ai)
#pragma unroll
            for (int m = 0; m < 4; ++m) { const int row = row0 + ai * HALF + m * 16; const float s = gw[row] * inscale; bf16_t* rowp = Y + (size_t)row * 1024 + col0;
#pragma unroll
                for (int bj = 0; bj < 2; ++bj) { const f32x4 v0 = acc[ai][bj][m][0] * s, v1 = acc[ai][bj][m][1] * s;
                    u32x4 w; w.x = cvt_pk_bf16(v0[0], v0[1]); w.y = cvt_pk_bf16(v0[2], v0[3]); w.z = cvt_pk_bf16(v1[0], v1[1]); w.w = cvt_pk_bf16(v1[2], v1[3]);
                    *(u32x4*)(rowp + bj * HALF) = w; } }
    }
};
struct EpiQKV {
    static constexpr bool PERM = true;
    bf16_t* Q; bf16_t* Kb; bf16_t* Vb; const float* qg; const float* kg; const float* ctab; const float* stab; float c2;
    __device__ __forceinline__ void operator()(const AccT& acc, const Unit& u, int wr, int wc, int fr, int fq) const {
        const int row0 = u.pm * BM + wr * 64 + fr; const bool ctx = u.pm >= 64; const int pn = u.pn;
        if (ctx && pn < 4) return;
        const float* gsrc = pn < 4 ? qg : kg;
        f32x4 gq[2][2];
#pragma unroll
        for (int bj = 0; bj < 2; ++bj)
#pragma unroll
            for (int n = 0; n < 2; ++n) gq[bj][n] = *(const f32x4*)(gsrc + 32 * bj + 8 * fq + 4 * n);
        const int fo = 8 * (fq & 1); const bool hf = (fq >> 1) != 0;
#pragma unroll
        for (int ai = 0; ai < 2; ++ai)
#pragma unroll
            for (int m = 0; m < 4; ++m) { const int row = row0 + ai * HALF + m * 16;
                int kvrow; int t = 0;
                if (ctx) { const int rc = row - 16384; kvrow = (rc >> 8) * 4352 + (rc & 255); } else { t = row & 4095; kvrow = (row >> 12) * 4352 + 256 + t; }
                if (pn == 5) {
#pragma unroll
                    for (int bj = 0; bj < 2; ++bj) { const f32x4 v0 = acc[ai][bj][m][0], v1 = acc[ai][bj][m][1];
                        u32x4 w; w.x = cvt_pk_bf16(v0[0], v0[1]); w.y = cvt_pk_bf16(v0[2], v0[3]); w.z = cvt_pk_bf16(v1[0], v1[1]); w.w = cvt_pk_bf16(v1[2], v1[3]);
                        *(u32x4*)(Vb + (size_t)kvrow * 256 + wc * 64 + 32 * bj + 8 * fq) = w; }
                } else {
                    float ss = 0.f;
#pragma unroll
                    for (int bj = 0; bj < 2; ++bj)
#pragma unroll
                        for (int n = 0; n < 2; ++n)
#pragma unroll
                            for (int j = 0; j < 4; ++j) { const float a = acc[ai][bj][m][n][j]; ss += a * a; }
                    ss += __shfl_xor(ss, 16); ss += __shfl_xor(ss, 32);
                    const float rstd = __builtin_amdgcn_rsqf(ss * (1.f / 64.f) + 1e-6f);
#pragma unroll
                    for (int bj = 0; bj < 2; ++bj) { f32x4 v[2];
#pragma unroll
                        for (int n = 0; n < 2; ++n) v[n] = acc[ai][bj][m][n] * rstd * gq[bj][n];
                        if (!ctx) { const int p = bj == 0 ? (t >> 6) : (t & 63);
#pragma unroll
                            for (int n = 0; n < 2; ++n) { const f32x4 cc = *(const f32x4*)(ctab + p * 16 + fo + 4 * n), sn = *(const f32x4*)(stab + p * 16 + fo + 4 * n);
#pragma unroll
                                for (int j = 0; j < 4; ++j) { const float own = v[n][j], oth = __shfl_xor(own, 32);
                                    v[n][j] = hf ? (own * cc[j] + oth * sn[j]) : (own * cc[j] - oth * sn[j]); } } }
                        if (pn < 4) { v[0] = v[0] * c2; v[1] = v[1] * c2; }
                        u32x4 w; w.x = cvt_pk_bf16(v[0][0], v[0][1]); w.y = cvt_pk_bf16(v[0][2], v[0][3]); w.z = cvt_pk_bf16(v[1][0], v[1][1]); w.w = cvt_pk_bf16(v[1][2], v[1][3]);
                        if (pn < 4) *(u32x4*)(Q + (size_t)row * 1024 + (4 * pn + wc) * 64 + 32 * bj + 8 * fq) = w;
                        else        *(u32x4*)(Kb + (size_t)kvrow * 256 + wc * 64 + 32 * bj + 8 * fq) = w; }
                } }
    }
};

typedef int v8i32 __attribute__((ext_vector_type(8))); typedef int v4i32 __attribute__((ext_vector_type(4)));
template <class Epi, class Sched, bool ALIGN_EPI = false, bool F8 = false>
__device__ __forceinline__ void gemm_phase(PG8_LAS unsigned char* lds, const int tid, const Gemm g, const Sched& S, const Epi& E) {
    const int wid = __builtin_amdgcn_readfirstlane(tid >> 6), lane = tid & 63, wr = wid >> 2, wc = wid & 3, fr = lane & 15, fq = lane >> 4;
    const int K = g.K, nt = K / BK;
    unsigned voffA[2], voffB[2];
#pragma unroll
    for (int i = 0; i < 2; ++i) { int R, C; stage_rc(tid * 16 + i * 8192, R, C); const int Rb = Epi::PERM ? ((R & ~31) + perm32(R & 31)) : R;
        voffA[i] = (unsigned)(R * g.lda + C) * 2u; voffB[i] = (unsigned)(Rb * K + C) * 2u; }
    const size_t kstep = (size_t)(BK * 2);
    const size_t hstep = (size_t)HALF * K * 2;
    const size_t tstep = 2 * hstep;
    const size_t hstepA = (size_t)HALF * g.lda * 2;
#define PG8_ABASE(u) ((const char*)g.A + ((size_t)(u).pm * BM * g.lda + (size_t)(u).pn * g.a_pn_stride) * 2)
    const unsigned ldsw = (unsigned)wid * 1024u;
    const int aoff = lds_byte(wr * 64 + fr, fq * 8), boff = lds_byte(wc * 32 + fr, fq * 8);
#define PG8_SA(b, h) (((b) * 2 + (h)) * HTB)
#define PG8_SB(b, h) ((4 + (b) * 2 + (h)) * HTB)
#define PG8_STAGE(bufoff, gbase, voff) do { _Pragma("unroll") for (int _i = 0; _i < 2; ++_i) \
        __builtin_amdgcn_global_load_lds((const unsigned*)((const char*)(gbase) + (voff)[_i]), (PG8_LAS unsigned*)(lds + (bufoff) + ldsw + _i * 8192), 16, 0, 0); } while (0)
#define PG8_LDA(dst, b, h) do { _Pragma("unroll") for (int m = 0; m < 4; ++m) _Pragma("unroll") for (int k = 0; k < 2; ++k) dst[m][k] = *(const PG8_LAS bf16x8*)(lds + PG8_SA(b, h) + aoff + m * 2048 + k * 1024); } while (0)
#define PG8_LDB(dst, b, h) do { _Pragma("unroll") for (int n = 0; n < 2; ++n) _Pragma("unroll") for (int k = 0; k < 2; ++k) dst[n][k] = *(const PG8_LAS bf16x8*)(lds + PG8_SB(b, h) + boff + n * 2048 + k * 1024); } while (0)
#define PG8_CAT8(x) __builtin_shufflevector(__builtin_bit_cast(v4i32, (x)[0]), __builtin_bit_cast(v4i32, (x)[1]), 0, 1, 2, 3, 4, 5, 6, 7)
#define PG8_MMA(ai, bj, At, Bt) do { __builtin_amdgcn_s_setprio(1); _Pragma("unroll") for (int m = 0; m < 4; ++m) _Pragma("unroll") for (int n = 0; n < 2; ++n) { \
        if constexpr (F8) { asm volatile("v_mfma_f32_16x16x128_f8f6f4 %0, %1, %2, %0" : "+v"(acc[ai][bj][m][n]) : "v"(PG8_CAT8(Bt[n])), "v"(PG8_CAT8(At[m]))); } \
        else { _Pragma("unroll") for (int k = 0; k < 2; ++k) acc[ai][bj][m][n] = __builtin_amdgcn_mfma_f32_16x16x32_bf16(Bt[n][k], At[m][k], acc[ai][bj][m][n], 0, 0, 0); } } \
        __builtin_amdgcn_s_setprio(0); } while (0)
#define PG8_WAIT_V(n) asm volatile("s_waitcnt vmcnt(" #n ")" ::: "memory")
#define PG8_WAIT_L(n) asm volatile("s_waitcnt lgkmcnt(" #n ")" ::: "memory")
#define PG8_BAR __builtin_amdgcn_s_barrier()
#define PG8_SCHED __builtin_amdgcn_sched_barrier(0)
    Unit cur, nxt; int ui = 0;
    if (!S.next(0, cur)) return;
    f32x4 acc[2][2][4][2];
#pragma unroll
    for (int a = 0; a < 2; ++a)
#pragma unroll
        for (int b = 0; b < 2; ++b)
#pragma unroll
            for (int m = 0; m < 4; ++m)
#pragma unroll
                for (int n = 0; n < 2; ++n) acc[a][b][m][n] = (f32x4){0.f, 0.f, 0.f, 0.f};
    bf16x8 At[4][2], B0[2][2], B1[2][2];
    const char* cA = PG8_ABASE(cur); const char* cB = (const char*)g.Bt + ((size_t)cur.e * g.b_e_stride) * 2 + (size_t)cur.pn * tstep;
    PG8_STAGE(PG8_SB(0, 0), cB, voffB); PG8_STAGE(PG8_SB(0, 1), cB + hstep, voffB); PG8_STAGE(PG8_SA(0, 0), cA, voffA); PG8_STAGE(PG8_SA(0, 1), cA + hstepA, voffA);
    if (wr == 1) PG8_BAR;
    PG8_WAIT_V(2); PG8_BAR;
    PG8_STAGE(PG8_SB(1, 0), cB + kstep, voffB); PG8_STAGE(PG8_SA(1, 0), cA + kstep, voffA); PG8_STAGE(PG8_SB(1, 1), cB + hstep + kstep, voffB);
    PG8_WAIT_V(6); PG8_BAR;
    for (;;) {
        const bool has_next = S.next(ui + 1, nxt);
        const char* nB = has_next ? (const char*)g.Bt + ((size_t)nxt.e * g.b_e_stride) * 2 + (size_t)nxt.pn * tstep : cB;
        const char* nA = has_next ? PG8_ABASE(nxt) : cA;
        for (int t = 0; t < nt; t += 2) {
            const bool last = (t == nt - 2);
            const char* a1 = cA + (size_t)(t + 1) * kstep;
            const char* a2 = last ? nA : cA + (size_t)(t + 2) * kstep; const char* b2 = last ? nB : cB + (size_t)(t + 2) * kstep;
            const char* a3 = a2 + kstep; const char* b3 = b2 + kstep;
            {
            PG8_LDB(B0, 0, 0); PG8_LDB(B1, 0, 1); PG8_SCHED; PG8_LDA(At, 0, 0); PG8_STAGE(PG8_SA(1, 1), a1 + hstepA, voffA);
            PG8_WAIT_V(8); PG8_WAIT_L(0); PG8_BAR; PG8_MMA(0, 0, At, B0); PG8_MMA(0, 1, At, B1); PG8_BAR; PG8_SCHED;
            PG8_LDA(At, 0, 1); PG8_STAGE(PG8_SB(0, 0), b2, voffB); PG8_STAGE(PG8_SB(0, 1), b2 + hstep, voffB); PG8_STAGE(PG8_SA(0, 0), a2, voffA);
            PG8_WAIT_V(8); PG8_WAIT_L(0); PG8_BAR; PG8_MMA(1, 0, At, B0); PG8_MMA(1, 1, At, B1); PG8_BAR; PG8_SCHED;
            PG8_LDB(B0, 1, 0); PG8_LDB(B1, 1, 1); PG8_SCHED; PG8_LDA(At, 1, 0); PG8_STAGE(PG8_SA(0, 1), a2 + hstepA, voffA);
            PG8_WAIT_V(8); PG8_WAIT_L(0); PG8_BAR; PG8_MMA(0, 0, At, B0); PG8_MMA(0, 1, At, B1); PG8_BAR; PG8_SCHED;
            PG8_LDA(At, 1, 1); PG8_STAGE(PG8_SB(1, 0), b3, voffB); PG8_STAGE(PG8_SB(1, 1), b3 + hstep, voffB); PG8_STAGE(PG8_SA(1, 0), a3, voffA);
            PG8_WAIT_V(8); PG8_WAIT_L(0); PG8_BAR; PG8_MMA(1, 0, At, B0); PG8_MMA(1, 1, At, B1); PG8_BAR; PG8_SCHED;
            }
        }
        if constexpr (ALIGN_EPI) { if (wr == 0) PG8_BAR; }
        if constexpr (F8) asm volatile("s_nop 15\n\ts_nop 15" ::: "memory");
        E(acc, cur, wr, wc, fr, fq);
        if (!has_next) break;
#pragma unroll
        for (int a = 0; a < 2; ++a)
#pragma unroll
            for (int b = 0; b < 2; ++b)
#pragma unroll
                for (int m = 0; m < 4; ++m)
#pragma unroll
                    for (int n = 0; n < 2; ++n) acc[a][b][m][n] = (f32x4){0.f, 0.f, 0.f, 0.f};
        cur = nxt; cA = nA; cB = nB; ++ui;
        if constexpr (ALIGN_EPI) { if (wr == 1) PG8_BAR; }
    }
    PG8_WAIT_V(0);
    if constexpr (!ALIGN_EPI) { if (wr == 0) PG8_BAR; }
    PG8_BAR;
#undef PG8_SA
#undef PG8_SB
#undef PG8_STAGE
#undef PG8_LDA
#undef PG8_LDB
#undef PG8_MMA
#undef PG8_WAIT_V
#undef PG8_WAIT_L
#undef PG8_BAR
#undef PG8_SCHED
#undef PG8_ABASE
#undef PG8_CAT8
}
}

namespace attn_body {
using bf16=__hip_bfloat16;
using bf16x8=__attribute__((ext_vector_type(8)))short;
using s16x4=__attribute__((ext_vector_type(4)))short;
using f32x16=__attribute__((ext_vector_type(16)))float;
using u32x4=__attribute__((ext_vector_type(4)))unsigned;
constexpr int BATCH=4,NHEAD=16,NKVH=4,SEQ=4096,SKV=4352,D=64,DM=NHEAD*D,KVP=NKVH*D;
constexpr int NW=8,QBLK=32,QB=QBLK*NW,KVBLK=64,NQB=SEQ/QB;
constexpr int ATTN_PITCH=DM, ATTN_UNIT_ROWS=QB;
__device__ __forceinline__ int crow(int r,int hi){return (r&3)+8*(r>>2)+4*hi;}
#define SBAR() __builtin_amdgcn_sched_barrier(0)
__device__ __forceinline__ void cmask(f32x16&p0,f32x16&p1,int jb,int qrel,int hi){
  const float NEG=-INFINITY; int kb=64*jb+4*hi;
  #pragma unroll
  for(int r=0;r<16;++r){int kv=kb+(r&3)+8*(r>>2); if(kv>qrel)p0[r]=NEG; if(kv+32>qrel)p1[r]=NEG;}
}

constexpr int NSLOT=3, SLOTB=8192;
constexpr int LDS_K=0, LDS_V=NSLOT*SLOTB, LDS_WS=2*NSLOT*SLOTB, LDS_OST=LDS_WS+NW*64*4, LDS_BYTES=LDS_OST+NW*4096;
constexpr float C2=0.125f*1.4426950408889634f;
__device__ __forceinline__ void glds16(const void*gsrc,unsigned lds_dst){unsigned keep;
  asm volatile("s_mov_b32 %0, m0\n\ts_mov_b32 m0, %2\n\ts_nop 0\n\tglobal_load_lds_dwordx4 %1, off\n\ts_mov_b32 m0, %0":"=&s"(keep):"v"(gsrc),"s"(lds_dst):"memory");}
__device__ __forceinline__ float max3f(float a,float b,float c){float r;asm("v_max3_f32 %0, %1, %2, %3":"=v"(r):"v"(a),"v"(b),"v"(c));return r;}
__device__ __forceinline__ float max2f(float a,float b){float r;asm("v_max_f32_e32 %0, %1, %2":"=v"(r):"v"(a),"v"(b));return r;}
__device__ __forceinline__ float fadd_s(float a,float b){float r;asm("v_add_f32_e32 %0, %1, %2":"=v"(r):"v"(a),"v"(b));return r;}
__device__ __forceinline__ float fsub_s(float a,float b){float r;asm("v_sub_f32_e32 %0, %1, %2":"=v"(r):"v"(a),"v"(b));return r;}
typedef float f32x2_t __attribute__((ext_vector_type(2))); typedef __bf16 bf16x2_t __attribute__((ext_vector_type(2)));
__device__ __forceinline__ unsigned cvtpk_s(float lo,float hi){f32x2_t v={lo,hi};bf16x2_t b=__builtin_convertvector(v,bf16x2_t);return __builtin_bit_cast(unsigned,b);}
#define WAIT_BAR(N) asm volatile("s_waitcnt vmcnt(" #N ") lgkmcnt(0)\n\ts_barrier":::"memory")

__device__ __forceinline__ void qkt(f32x16&p0,f32x16&p1,const char*Kslot,const bf16x8*qr,const f32x16&negm,int r32,int hi){
  const char*kb=Kslot+hi*1024+r32*16;
  #pragma unroll
  for(int d0=0;d0<4;++d0){
    const bf16x8 b0=*reinterpret_cast<const bf16x8*>(kb+d0*2048);
    const bf16x8 b1=*reinterpret_cast<const bf16x8*>(kb+d0*2048+512);
    if(d0==0){p0=__builtin_amdgcn_mfma_f32_32x32x16_bf16(b0,qr[0],negm,0,0,0);p1=__builtin_amdgcn_mfma_f32_32x32x16_bf16(b1,qr[0],negm,0,0,0);}
    else{p0=__builtin_amdgcn_mfma_f32_32x32x16_bf16(b0,qr[d0],p0,0,0,0);p1=__builtin_amdgcn_mfma_f32_32x32x16_bf16(b1,qr[d0],p1,0,0,0);}}
}
typedef __attribute__((address_space(3))) const char* lds_cptr;
typedef short v4i16_t __attribute__((ext_vector_type(4)));
__device__ __forceinline__ void kload8(bf16x8*kf,lds_cptr kp){
  kf[0]=*(const __attribute__((address_space(3))) bf16x8*)(kp);      kf[1]=*(const __attribute__((address_space(3))) bf16x8*)(kp+512);
  kf[2]=*(const __attribute__((address_space(3))) bf16x8*)(kp+2048); kf[3]=*(const __attribute__((address_space(3))) bf16x8*)(kp+2560);
  kf[4]=*(const __attribute__((address_space(3))) bf16x8*)(kp+4096); kf[5]=*(const __attribute__((address_space(3))) bf16x8*)(kp+4608);
  kf[6]=*(const __attribute__((address_space(3))) bf16x8*)(kp+6144); kf[7]=*(const __attribute__((address_space(3))) bf16x8*)(kp+6656);
}
__device__ __forceinline__ void kload2(bf16x8*kf,lds_cptr kp,int j){ kf[2*j]=*(const __attribute__((address_space(3))) bf16x8*)(kp+j*2048); kf[2*j+1]=*(const __attribute__((address_space(3))) bf16x8*)(kp+j*2048+512); }
__device__ __forceinline__ s16x4 vtr(lds_cptr p){ return __builtin_bit_cast(s16x4,__builtin_amdgcn_ds_read_tr16_b64_v4i16((__attribute__((address_space(3))) v4i16_t*)p)); }
__device__ __forceinline__ float rowmax(const f32x16&p0,const f32x16&p1){
  float a=max3f(p0[0],p0[1],p1[0]),b=max3f(p0[2],p0[3],p1[1]);a=max3f(a,p1[2],p1[3]);
  #pragma unroll
  for(int r=4;r<16;r+=4){a=max3f(a,p0[r],p0[r+1]);b=max3f(b,p0[r+2],p0[r+3]);a=max3f(a,p1[r],p1[r+1]);b=max3f(b,p1[r+2],p1[r+3]);}
  const float m=max2f(a,b);
  auto rr=__builtin_amdgcn_permlane32_swap(__float_as_uint(m),__float_as_uint(m),false,false);
  return max2f(__uint_as_float(rr[0]),__uint_as_float(rr[1]));
}
__device__ __forceinline__ void pv(f32x16*o,int vb,bf16x8 pa0,bf16x8 pa1,bf16x8 pa2,bf16x8 pa3){
  #pragma unroll
  for(int d0=0;d0<2;++d0){s16x4 lo[4],hi[4];
    #pragma unroll
    for(int ks=0;ks<4;++ks){
      asm volatile("ds_read_b64_tr_b16 %0,%1 offset:%c2":"=&v"(lo[ks]):"v"(vb),"i"(d0*4096+ks*1024):"memory");
      asm volatile("ds_read_b64_tr_b16 %0,%1 offset:%c2":"=&v"(hi[ks]):"v"(vb),"i"(d0*4096+ks*1024+512):"memory");}
    asm volatile("s_waitcnt lgkmcnt(0)":::"memory");SBAR();
    #define PK(k) (bf16x8){lo[k][0],lo[k][1],lo[k][2],lo[k][3],hi[k][0],hi[k][1],hi[k][2],hi[k][3]}
    o[d0]=__builtin_amdgcn_mfma_f32_32x32x16_bf16(pa0,PK(0),o[d0],0,0,0);
    o[d0]=__builtin_amdgcn_mfma_f32_32x32x16_bf16(pa1,PK(1),o[d0],0,0,0);
    o[d0]=__builtin_amdgcn_mfma_f32_32x32x16_bf16(pa2,PK(2),o[d0],0,0,0);
    o[d0]=__builtin_amdgcn_mfma_f32_32x32x16_bf16(pa3,PK(3),o[d0],0,0,0);
    #undef PK
  }
}

#ifndef ATTN_STORE16
#define ATTN_STORE16(p,v) (*(u32x4*)(p)=(v))
#endif
template<int THRL> __device__ __forceinline__ void attn_unit(const int tid,int b,int h,int qb,const bf16*Q,const bf16*__restrict__ K,const bf16*__restrict__ V,bf16*O,char*shm){
  const int lane=tid&63,r32=lane&31,hi=lane>>5; const int wid=__builtin_amdgcn_readfirstlane(tid>>6);
  const long rowbase=(long)b*SEQ; const int q0=qb*QB;
  const bf16*Qw=Q+(rowbase+q0+wid*QBLK)*DM+h*D;
  const bf16*Kh=K+(long)b*SKV*KVP+(h>>2)*D,*Vh=V+(long)b*SKV*KVP+(h>>2)*D;
  const unsigned lds0=(unsigned)(uintptr_t)shm;
  float*wsf=(float*)(shm+LDS_WS)+wid*64;
  const bf16*ksrc=Kh+(long)lane*KVP+wid*8;
  const bf16*vsrc=Vh+(long)(16*(wid&3)+(lane>>2))*KVP+(wid>>2)*32+(lane&3)*8;
  const unsigned kdst=lds0+LDS_K+wid*1024, vdst=lds0+LDS_V+wid*1024;
  #define DMA_K(t,slot) glds16(ksrc+(long)(t)*KVBLK*KVP,(unsigned)__builtin_amdgcn_readfirstlane(kdst+(slot)))
  #define DMA_V(t,slot) glds16(vsrc+(long)(t)*KVBLK*KVP,(unsigned)__builtin_amdgcn_readfirstlane(vdst+(slot)))
  const int vb0=(int)(lds0+LDS_V)+((lane>>4)&1)*32+(lane&3)*8+(4*hi+((lane&15)>>2))*64;
  const char*Kbase=shm+LDS_K; bf16x8 kf[8];
  const lds_cptr shm3=(lds_cptr)shm; const lds_cptr kp0=shm3+LDS_K+hi*1024+r32*16; const lds_cptr vp0=shm3+LDS_V+((lane>>4)&1)*32+(lane&3)*8+(4*hi+((lane&15)>>2))*64;
  int NT=SKV/KVBLK; asm volatile("":"+s"(NT));
  DMA_K(0,0);DMA_V(0,0);DMA_K(1,SLOTB);
  bf16x8 qr[4];
  #pragma unroll
  for(int d0=0;d0<4;++d0)qr[d0]=*reinterpret_cast<const bf16x8*>(&Qw[(long)r32*DM+d0*16+hi*8]);
  float mhat=0.f,l_reg=0.f;f32x16 o[2];o[0]=f32x16{};o[1]=f32x16{};f32x16 negm=f32x16{};asm volatile("":"+v"(negm));
  #define CMASK(P0,P1,t) do{}while(0)
  bool resc=false;
  #define START(P0,P1) do{ const float rm=rowmax(P0,P1); resc=false; \
    { const float dl=rm; mhat=fadd_s(mhat,dl); \
      _Pragma("unroll") for(int r=0;r<16;++r){P0[r]=fsub_s(P0[r],dl);P1[r]=fsub_s(P1[r],dl);} \
      _Pragma("unroll") for(int r=0;r<16;++r)negm[r]=-mhat; asm volatile("":"+v"(negm)); } \
    _Pragma("unroll") for(int r=0;r<16;++r)P0[r]=__builtin_amdgcn_exp2f(P0[r]); }while(0)
  #define RESC() do{ if(resc){ asm volatile("s_waitcnt lgkmcnt(0)":::"memory"); \
      _Pragma("unroll") for(int d_=0;d_<2;++d_) _Pragma("unroll") for(int r=0;r<16;++r)o[d_][r]*=wsf[crow(r,hi)]; } }while(0)
  f32x16 pA0,pA1,pB0,pB1;
  int sl_prev=0,sl_cur=0,sl_next=SLOTB;
  #define ROT() do{sl_prev=sl_cur;sl_cur=sl_next;sl_next=(sl_next==(NSLOT-1)*SLOTB)?0:sl_next+SLOTB;}while(0)
  DMA_K(2,2*SLOTB);
  WAIT_BAR(3);
  qkt(pA0,pA1,Kbase,qr,negm,r32,hi);asm volatile("s_nop 15\n\ts_nop 7":"+v"(pA0),"+v"(pA1));CMASK(pA0,pA1,0);
  START(pA0,pA1);
  _Pragma("unroll") for(int r=0;r<16;++r)pA1[r]=__builtin_amdgcn_exp2f(pA1[r]);
  WAIT_BAR(0);
  DMA_K(3,0);DMA_V(1,SLOTB);
  ROT();
  kload8(kf,kp0+sl_cur);
  WAIT_BAR(2);
  s16x4 vlo[8],vhi[8]; u32x4 pw0,pw1,pw2,pw3;
  #define PKW(P,B) cvtpk_s(P[B],P[B+1])
  #define PAF(k) __builtin_bit_cast(bf16x8,pw##k)
  #define VFR(i) (bf16x8){vlo[i][0],vlo[i][1],vlo[i][2],vlo[i][3],vhi[i][0],vhi[i][1],vhi[i][2],vhi[i][3]}
  #define PIN(x) asm volatile("":"+v"(x))
  #define MX3(a,b,c) __builtin_fmaxf(__builtin_fmaxf((a),(b)),(c))
  #define GAPA(MF,A0,A1,A2,A3,W0,W1,PW) do{ MF; sacc+=A0; sacc+=A1; sacc+=A2; sacc+=A3; PIN(sacc); W0; W1; PIN(PW); SBAR(); }while(0)
  #define EX(v) __builtin_amdgcn_exp2f(v)
  #define GAPB(MF,X,B) do{ MF; X[B]=EX(X[B]); X[B+1]=EX(X[B+1]); X[B+2]=EX(X[B+2]); X[B+3]=EX(X[B+3]); PIN(X); SBAR(); }while(0)
  #define VRD(i) do{ vlo[i]=vtr(vp_+(((i)>>2)*4096+((i)&3)*1024)); vhi[i]=vtr(vp_+(((i)>>2)*4096+((i)&3)*1024+512)); }while(0)
  #define KRD(G,j) do{ if(G){ kload2(kf,kp0+sl_next,j); SBAR(); } }while(0)
  #define STEP(C0,C1,P0,P1,t,GK,GV,GL) do{ SBAR(); \
    const lds_cptr vp_=vp0+sl_prev; \
    VRD(0); SBAR(); float sacc=(P0[0]+P0[1]); \
    GAPA(C0=__builtin_amdgcn_mfma_f32_32x32x16_bf16(kf[0],qr[0],negm,0,0,0), P0[2],P0[3],P0[4],P0[5],     pw0[0]=PKW(P0,0), pw0[1]=PKW(P0,2), pw0); \
    VRD(4); SBAR(); GAPA(C1=__builtin_amdgcn_mfma_f32_32x32x16_bf16(kf[1],qr[0],negm,0,0,0), P0[6],P0[7],P0[8],P0[9],     pw0[2]=PKW(P0,4), pw0[3]=PKW(P0,6), pw0); \
    VRD(1); SBAR(); GAPA(C0=__builtin_amdgcn_mfma_f32_32x32x16_bf16(kf[2],qr[1],C0,0,0,0),   P0[10],P0[11],P0[12],P0[13], pw1[0]=PKW(P0,8), pw1[1]=PKW(P0,10), pw1); \
    VRD(5); SBAR(); GAPA(C1=__builtin_amdgcn_mfma_f32_32x32x16_bf16(kf[3],qr[1],C1,0,0,0),   P0[14],P0[15],P1[0],P1[1],   pw1[2]=PKW(P0,12),pw1[3]=PKW(P0,14), pw1); \
    VRD(2); SBAR(); GAPA(C0=__builtin_amdgcn_mfma_f32_32x32x16_bf16(kf[4],qr[2],C0,0,0,0),   P1[2],P1[3],P1[4],P1[5],     pw2[0]=PKW(P1,0), pw2[1]=PKW(P1,2), pw2); \
    VRD(6); SBAR(); GAPA(C1=__builtin_amdgcn_mfma_f32_32x32x16_bf16(kf[5],qr[2],C1,0,0,0),   P1[6],P1[7],P1[8],P1[9],     pw2[2]=PKW(P1,4), pw2[3]=PKW(P1,6), pw2); \
    VRD(3); SBAR(); GAPA(C0=__builtin_amdgcn_mfma_f32_32x32x16_bf16(kf[6],qr[3],C0,0,0,0),   P1[10],P1[11],P1[12],P1[13], pw3[0]=PKW(P1,8), pw3[1]=PKW(P1,10), pw3); \
    VRD(7); SBAR(); GAPA(C1=__builtin_amdgcn_mfma_f32_32x32x16_bf16(kf[7],qr[3],C1,0,0,0),   P1[14],P1[15],0.f,0.f,       pw3[2]=PKW(P1,12),pw3[3]=PKW(P1,14), pw3); \
    l_reg+=sacc; \
    if(GK){DMA_K((t)+3,sl_cur);} if(GV){DMA_V((t)+1,sl_next);} \
    CMASK(C0,C1,t); \
    { float a=MX3(C0[0],C0[1],C1[0]),b=MX3(C0[2],C0[3],C1[1]); a=MX3(a,C1[2],C1[3]); \
      _Pragma("unroll") for(int r=4;r<16;r+=4){a=MX3(a,C0[r],C0[r+1]);b=MX3(b,C0[r+2],C0[r+3]);a=MX3(a,C1[r],C1[r+1]);b=MX3(b,C1[r+2],C1[r+3]);} \
      float rm=__builtin_fmaxf(a,b); { auto rr=__builtin_amdgcn_permlane32_swap(__float_as_uint(rm),__float_as_uint(rm),false,false); rm=__builtin_fmaxf(__uint_as_float(rr[0]),__uint_as_float(rr[1])); } \
      resc=false; \
      if(__builtin_expect(__any(rm>(float)THRL),0)){ const float dl=__builtin_fmaxf(rm,0.f); mhat+=dl; \
        _Pragma("unroll") for(int r=0;r<16;++r){C0[r]-=dl;C1[r]-=dl;} \
        _Pragma("unroll") for(int r=0;r<16;++r)negm[r]=-mhat; asm volatile("":"+v"(negm)); \
        const float f=__builtin_amdgcn_exp2f(-dl); l_reg*=f; if(hi==0)wsf[r32]=f; resc=true; } } \
    SBAR(); \
    GAPB(o[0]=__builtin_amdgcn_mfma_f32_32x32x16_bf16(PAF(0),VFR(0),o[0],0,0,0), C0,0); \
    GAPB(o[1]=__builtin_amdgcn_mfma_f32_32x32x16_bf16(PAF(0),VFR(4),o[1],0,0,0), C0,4); \
    KRD(GL,0); GAPB(o[0]=__builtin_amdgcn_mfma_f32_32x32x16_bf16(PAF(1),VFR(1),o[0],0,0,0), C0,8); \
    KRD(GL,1); GAPB(o[1]=__builtin_amdgcn_mfma_f32_32x32x16_bf16(PAF(1),VFR(5),o[1],0,0,0), C0,12); \
    KRD(GL,2); GAPB(o[0]=__builtin_amdgcn_mfma_f32_32x32x16_bf16(PAF(2),VFR(2),o[0],0,0,0), C1,0); \
    KRD(GL,3); GAPB(o[1]=__builtin_amdgcn_mfma_f32_32x32x16_bf16(PAF(2),VFR(6),o[1],0,0,0), C1,4); \
    GAPB(o[0]=__builtin_amdgcn_mfma_f32_32x32x16_bf16(PAF(3),VFR(3),o[0],0,0,0), C1,8); \
    GAPB(o[1]=__builtin_amdgcn_mfma_f32_32x32x16_bf16(PAF(3),VFR(7),o[1],0,0,0), C1,12); \
    }while(0)
  int t=1;
  #undef CMASK
  #define CMASK(P0,P1,t) do{}while(0)
  for(;t+5<NT;t+=2){
    STEP(pB0,pB1,pA0,pA1,t,true,true,true);     WAIT_BAR(2); RESC(); ROT();
    STEP(pA0,pA1,pB0,pB1,t+1,true,true,true);   WAIT_BAR(2); RESC(); ROT();
  }
  #undef CMASK
  #define CMASK(P0,P1,t) do{}while(0)
  #define ENDW(tt) do{ if((tt)+3<NT){WAIT_BAR(2);} else if((tt)+2<NT){WAIT_BAR(1);} else {WAIT_BAR(0);} }while(0)
  for(;t+1<NT;t+=2){
    STEP(pB0,pB1,pA0,pA1,t,(t+3<NT),(t+1<NT),(t+1<NT));       ENDW(t);   RESC(); ROT();
    STEP(pA0,pA1,pB0,pB1,t+1,(t+4<NT),(t+2<NT),(t+2<NT));     ENDW(t+1); RESC(); ROT();
  }
  STEP(pB0,pB1,pA0,pA1,NT-1,false,false,false); RESC();
  { float sacc=pB0[0]+pB0[1]; _Pragma("unroll") for(int r=2;r<16;++r)sacc+=pB0[r]; _Pragma("unroll") for(int r=0;r<16;++r)sacc+=pB1[r]; l_reg+=sacc;
    pw0=(u32x4){PKW(pB0,0),PKW(pB0,2),PKW(pB0,4),PKW(pB0,6)};pw1=(u32x4){PKW(pB0,8),PKW(pB0,10),PKW(pB0,12),PKW(pB0,14)};pw2=(u32x4){PKW(pB1,0),PKW(pB1,2),PKW(pB1,4),PKW(pB1,6)};pw3=(u32x4){PKW(pB1,8),PKW(pB1,10),PKW(pB1,12),PKW(pB1,14)};
    SBAR(); pv(o,vb0+sl_cur,PAF(0),PAF(1),PAF(2),PAF(3)); }
  #undef PKW
  #undef PAF
  #undef VFR
  #undef PIN
  #undef MX3
  #undef GAPA
  #undef GAPB
  #undef EX
  #undef VRD
  #undef KRD
  #undef STEP
  #undef ENDW
  {auto rr=__builtin_amdgcn_permlane32_swap(__float_as_uint(l_reg),__float_as_uint(l_reg),false,false);l_reg=__uint_as_float(rr[0])+__uint_as_float(rr[1]);}
  if(hi==0)wsf[32+r32]=l_reg;asm volatile("s_waitcnt lgkmcnt(0)":::"memory");
  float rli[16];
  #pragma unroll
  for(int r=0;r<16;++r)rli[r]=__builtin_amdgcn_rcpf(wsf[32+crow(r,hi)]);
  bf16*Ow=O+(rowbase+q0+wid*QBLK)*DM+h*D;
  { bf16*stg=(bf16*)(shm+LDS_OST)+wid*2048;
    #pragma unroll
    for(int r=0;r<16;++r){const int orow=crow(r,hi);
      #pragma unroll
      for(int d0=0;d0<2;++d0)stg[orow*64+d0*32+r32]=__float2bfloat16(o[d0][r]*rli[r]);}
    asm volatile("s_waitcnt lgkmcnt(0)":::"memory");
    #pragma unroll
    for(int i=0;i<4;++i){const int row=i*8+(lane>>3),ch=lane&7; const u32x4 v=*(const u32x4*)(stg+row*64+ch*8); ATTN_STORE16(Ow+(long)row*DM+ch*8,v);} }
  asm volatile("s_waitcnt lgkmcnt(0)\n\ts_barrier":::"memory");
  #undef DMA_K
  #undef DMA_V
  #undef CMASK
  #undef START
  #undef RESC
  #undef ROT
}
constexpr int ATTN_LDS_BYTES=LDS_BYTES;
struct AttnTensors { const bf16* Q; const bf16* K; const bf16* V; bf16* O; };
struct AttnUnit { int bh; int qb; };
struct StaticOrder {
  int vcu,G,per;
  __device__ __forceinline__ explicit StaticOrder(int grid,int vcu_):vcu(vcu_),G(grid),per((BATCH*NHEAD*NQB+grid-1)/grid){}
  __device__ __forceinline__ bool next(int i,AttnUnit&u)const{ if(i>=per)return false; const int idx=vcu*per+i; if(idx>=BATCH*NHEAD*NQB)return false; u.bh=idx/NQB; u.qb=idx%NQB; return true; }
  __device__ __forceinline__ void a_ready(const AttnUnit&)const{}
  __device__ __forceinline__ void done(const AttnUnit&)const{}
};
template<class Sched,int THRL=8> __device__ __forceinline__ void attn_phase(const int tid,char*lds,const AttnTensors&T,const Sched&S){
  AttnUnit u;
  for(int i=0;S.next(i,u);++i){ S.a_ready(u); attn_unit<THRL>(tid,u.bh/NHEAD,u.bh%NHEAD,u.qb,T.Q,T.K,T.V,T.O,lds); S.done(u); }
}
#undef SBAR
#undef WAIT_BAR
}

constexpr int NWAVES = 8;
#ifndef MK_PER_PHASE
#define MK_PER_PHASE 0
#endif
#ifndef DUP_PHASE
#define DUP_PHASE (-1)
#endif
#ifndef DBG_STOP
#define DBG_STOP 99
#endif
constexpr int NPH = 32;

constexpr int D = 1024, NB = 4, SEQ = 4096, TL = NB * SEQ, CTXL = 256, TC = NB * CTXL, TT = TL + TC;
constexpr int ADIM = 2048, FF = 2816, ED = 3584, NE = 8, QKVW = 1536, SKV = CTXL + SEQ;
constexpr int MPAD = 136 * 256;
constexpr float EPS = 1e-6f;
constexpr float W8_SCALE = 512.f, A8_SCALE = 16.f, H8_SCALE = 8.f;

constexpr size_t MiB = 1u << 20, KiB = 1u << 10;
constexpr size_t WS_CTL = 0, CTL_ZERO_BYTES = 64 * KiB;
constexpr size_t WS_MODS = 1 * MiB;
constexpr size_t WS_TAB = 2 * MiB;
constexpr size_t WS_TOKE = 2 * MiB + 64 * KiB, WS_TOKS = WS_TOKE + 128 * KiB, WS_TOKG = WS_TOKS + 128 * KiB, WS_PROW = WS_TOKG + 128 * KiB, WS_GW = WS_PROW + 128 * KiB;
constexpr size_t WS_RSP = 4 * MiB;
constexpr size_t W_IN = 8 * MiB, W_OUT = 24 * MiB, W_QKV = 32 * MiB, W_O = 35 * MiB, W_P = 37 * MiB, W_GU = 38 * MiB, W_DN = 60 * MiB, M_GU = 71 * MiB, M_DN = 295 * MiB;
constexpr size_t WS_XS = 407 * MiB, WS_H = 475 * MiB, WS_BIG = 509 * MiB, WS_R2 = 747 * MiB, WS_END = 815 * MiB;
constexpr size_t WS_MODP = WS_R2;
static_assert(WS_GW + MPAD * 4 <= 4 * MiB && WS_MODS + 4 * 5 * 6144 * 4 <= WS_TAB && WS_RSP + (size_t)TT * 32 * 4 <= W_IN, "small-buffer map");
static_assert(M_DN + (size_t)16 * D * ED * 2 == WS_XS && WS_XS + (size_t)TT * D * 4 == WS_H && WS_H + (size_t)TT * D * 2 == WS_BIG && WS_BIG + (size_t)MPAD * ED * 2 == WS_R2 && WS_R2 + (size_t)MPAD * D * 2 == WS_END, "d_ws map");
constexpr int CW_TMO = 0, CW_CODE = 1, CW_BAR = 4096, CW_CNT = 8192;

constexpr int RING_OFF = 0, RING_BYTES = 131072;
constexpr int LDSCTL_OFF = RING_BYTES, MISC_OFF = LDSCTL_OFF + 320;
constexpr int LDS_BYTES = 147456;
static_assert(MISC_OFF + 128 <= LDS_BYTES, "LDS map");

#define GAS __attribute__((address_space(1)))
#define LAS __attribute__((address_space(3)))
typedef unsigned short bf16;
typedef unsigned v4u __attribute__((ext_vector_type(4)));
typedef float f32x4 __attribute__((ext_vector_type(4)));
typedef short bf16x8 __attribute__((ext_vector_type(8)));
typedef GAS unsigned gu32;
typedef GAS unsigned long long gu64;
#define RLX_AGENT __ATOMIC_RELAXED, __HIP_MEMORY_SCOPE_AGENT
#define LDS_WAIT() asm volatile("s_waitcnt lgkmcnt(0)" ::: "memory")
#define VM_WAIT() asm volatile("s_waitcnt vmcnt(0)" ::: "memory")
__device__ __forceinline__ unsigned long long rt() { return __builtin_amdgcn_s_memrealtime(); }
__device__ __forceinline__ unsigned f2bf(float f) { unsigned u = __builtin_bit_cast(unsigned, f); return (u + 0x7fffu + ((u >> 16) & 1u)) >> 16; }
__device__ __forceinline__ unsigned pk2(float lo, float hi) { return f2bf(lo) | (f2bf(hi) << 16); }

#define XB_TMO      128
#define XB_XCNT(j)  (256  + 64 * (j))
#define XB_XSUB(j)  (1280 + 64 * (j))
#define XB_XGEN(j)  (2304 + 64 * (j))
#define XB_TOP      3328
#define XB_TOPGEN   3392
#define XCD_BAR_WORDS 3456
#define XB_SPIN_CAP (1u << 18)

__device__ __forceinline__ unsigned xb_ld(unsigned* p)              { return __hip_atomic_load(p, __ATOMIC_RELAXED, __HIP_MEMORY_SCOPE_AGENT); }
__device__ __forceinline__ unsigned xb_add(unsigned* p, unsigned v) { return __hip_atomic_fetch_add(p, v, __ATOMIC_RELAXED, __HIP_MEMORY_SCOPE_AGENT); }
__device__ __forceinline__ unsigned xb_xcc_id() { return (unsigned)__builtin_amdgcn_s_getreg((3 << 11) | 20) & 0xFu; }
#define XB_SPIN(cond, bar) do { unsigned _sp = 0; while (cond) { __builtin_amdgcn_s_sleep(1); \
    if ((++_sp & 255u) == 0u) { if (xb_ld(&(bar)[XB_TMO])) break; if (_sp > XB_SPIN_CAP) { atomicAdd(&(bar)[XB_TMO], 1u); break; } } } } while (0)

struct XcdBarrier {
    unsigned* bar; unsigned x;
    volatile LAS unsigned* st;
};

__device__ __forceinline__ XcdBarrier xcd_barrier_post(unsigned* bar, volatile LAS unsigned* st, const int tid) {
    XcdBarrier b; b.bar = bar; b.x = xb_xcc_id(); b.st = st;
    if (tid == 0) (void)xb_add(&bar[XB_XCNT(b.x)], 1u);
    return b;
}
__device__ __forceinline__ void xcd_barrier_complete(unsigned* bar, unsigned x, unsigned& nloc, unsigned& nx) {
    const unsigned G = gridDim.x * gridDim.y * gridDim.z;
    unsigned sum, cnt, mine, sp = 0u;
    for (;;) {
        sum = 0u; cnt = 0u; mine = 0u;
#pragma unroll
        for (unsigned j = 0; j < 16; ++j) { const unsigned c = xb_ld(&bar[XB_XCNT(j)]); sum += c; cnt += (c > 0u) ? 1u : 0u; mine = (j == x) ? c : mine; }
        if (sum == G) break;
        __builtin_amdgcn_s_sleep(1);
        if ((++sp & 255u) == 0u) { if (xb_ld(&bar[XB_TMO])) break; if (sp > XB_SPIN_CAP) { atomicAdd(&bar[XB_TMO], 1u); break; } }
    }
    nloc = mine > 0u ? mine : 1u; nx = cnt > 0u ? cnt : 1u;
}

__device__ __forceinline__ void xcd_barrier(const XcdBarrier& b, const int tid) {
    asm volatile("s_waitcnt vmcnt(0)" ::: "memory");
    __syncthreads();
    if (tid == 0) {
        unsigned* bar = b.bar;
        __builtin_amdgcn_s_waitcnt(0);
        unsigned nloc = b.st[0], nx = b.st[1];
        if (nloc == 0u) { xcd_barrier_complete(bar, b.x, nloc, nx); b.st[0] = nloc; b.st[1] = nx; }
        const unsigned old = xb_add(&bar[XB_XSUB(b.x)], 1u);
        const unsigned gen = old / nloc;
        if (old + 1u == (gen + 1u) * nloc) {
            __builtin_amdgcn_fence(__ATOMIC_RELEASE, "agent");
            asm volatile("s_waitcnt vmcnt(0)" ::: "memory");
            const unsigned og = xb_add(&bar[XB_TOP], 1u);
            const unsigned tg = og / nx;
            if (og + 1u == (tg + 1u) * nx) xb_add(&bar[XB_TOPGEN], 1u);
            else XB_SPIN(xb_ld(&bar[XB_TOPGEN]) == tg, bar);
            __builtin_amdgcn_fence(__ATOMIC_ACQUIRE, "agent");
            xb_add(&bar[XB_XGEN(b.x)], 1u);
            asm volatile("s_waitcnt vmcnt(0)" ::: "memory");
        } else {
            XB_SPIN(xb_ld(&bar[XB_XGEN(b.x)]) == gen, bar);
            __builtin_amdgcn_fence(__ATOMIC_ACQUIRE, "agent");
            asm volatile("s_waitcnt vmcnt(0)" ::: "memory");
        }
    }
    __syncthreads();
}


typedef pg8::f32x2 f32x2; typedef pg8::u32x2 u32x2; typedef pg8::u32x4 u32x4;
using pg8::cvt_pk_bf16; using pg8::bf_lo; using pg8::bf_hi;

__device__ __forceinline__ float wave_sum(float v) {
#pragma unroll
    for (int o = 1; o < 64; o <<= 1) v += __shfl_xor(v, o);
    return v;
}

__device__ __forceinline__ void transpose_item(const float* __restrict__ W, int K, int N, bf16* WT, int kb, int nb, int prow0, LAS float* scr, int lane) {
    const int k0 = 64 * kb, n0 = 32 * nb;
#pragma unroll 8
    for (int i = 0; i < 32; ++i) { const int kk = 2 * i + (lane >> 5); scr[kk * 33 + (lane & 31)] = W[(size_t)(k0 + kk) * N + n0 + (lane & 31)]; }
    LDS_WAIT(); asm volatile("" ::: "memory");
    const int c = lane & 7;
#pragma unroll
    for (int j = 0; j < 4; ++j) { const int n = (lane >> 3) + 8 * j; const LAS float* s = scr + (8 * c) * 33 + n;
        v4u o; o.x = pk2(s[0 * 33], s[1 * 33]); o.y = pk2(s[2 * 33], s[3 * 33]); o.z = pk2(s[4 * 33], s[5 * 33]); o.w = pk2(s[6 * 33], s[7 * 33]);
        *(GAS v4u*)(WT + (size_t)(prow0 + n) * K + k0 + 8 * c) = o; }
    LDS_WAIT(); asm volatile("" ::: "memory");
}
__device__ __forceinline__ void transpose_item8(const float* __restrict__ W, int K, int N, unsigned char* WT, int kb, int nb, int prow0, float scale, LAS float* scr, int lane) {
    const int k0 = 64 * kb, n0 = 32 * nb;
#pragma unroll 8
    for (int i = 0; i < 32; ++i) { const int kk = 2 * i + (lane >> 5); scr[kk * 33 + (lane & 31)] = W[(size_t)(k0 + kk) * N + n0 + (lane & 31)]; }
    LDS_WAIT(); asm volatile("" ::: "memory");
    const int c = lane & 7;
#pragma unroll
    for (int j = 0; j < 4; ++j) { const int n = (lane >> 3) + 8 * j; const LAS float* s = scr + (8 * c) * 33 + n;
        u32x2 o; o.x = pg8::pk4_fp8(s[0 * 33] * scale, s[1 * 33] * scale, s[2 * 33] * scale, s[3 * 33] * scale); o.y = pg8::pk4_fp8(s[4 * 33] * scale, s[5 * 33] * scale, s[6 * 33] * scale, s[7 * 33] * scale);
        *(GAS u32x2*)(WT + (size_t)(prow0 + n) * K + k0 + 8 * c) = o; }
    LDS_WAIT(); asm volatile("" ::: "memory");
}
__device__ __forceinline__ int gu_row(int c0, int up) { return (c0 >> 7) * 256 + (c0 & 127) + (up ? 128 : 0); }
__device__ __forceinline__ int qkv_row(int l0) { const int pn = l0 >> 8, wc = (l0 & 255) >> 6, bj = (l0 & 63) >> 5; return 256 * pn + 128 * bj + 32 * wc; }

struct In {
    const float *x, *c, *ctx, *c_ctx, *ada_w, *ada_b, *norm_g, *a_w_in, *a_v_g, *a_ws, *a_bs, *a_w_out, *b_w_qkv, *b_q_g, *b_k_g, *b_w_o, *p_w, *p_scale,
                *f_w_gate, *f_w_up, *f_w_down, *m_router, *m_w_gate, *m_w_up, *m_w_down;
};

__device__ __forceinline__ void p1_convert(const In& I, unsigned char* ws, LAS unsigned char* lds, int lane, int wave, int G) {
    LAS float* scr = (LAS float*)(lds + RING_OFF + wave * 16384);
    const int gw = (int)blockIdx.x * NWAVES + wave, NGW = G * NWAVES;
    for (int it = gw; it < 4 * 5 * 6144 / 256; it += NGW) { const int idx = it * 256 + lane * 4, i = idx / (5 * 6144), col = idx % 6144;
        f32x4 a = *(const f32x4*)(I.ada_b + i * 6144 + col);
#pragma unroll
        for (int kc = 0; kc < 8; ++kc) a = a + *(const f32x4*)((const float*)(ws + WS_MODP) + (size_t)kc * (4 * 5 * 6144) + idx);
        *(f32x4*)((float*)(ws + WS_MODS) + idx) = a; }
    constexpr int IPM = 1792, IPE = 3 * IPM, NMOE = 16 * IPE;
    for (int it = gw; it < NMOE; it += NGW) {
        const int le = it / IPE, r = it - le * IPE, which = r / IPM, q = r - which * IPM;
        if (which < 2) { const int kb = q / 112, nb = q - kb * 112; const float* W = (which ? I.m_w_up : I.m_w_gate) + (size_t)le * D * ED;
            transpose_item8(W, D, ED, ws + M_GU + (size_t)le * 2 * ED * D, kb, nb, gu_row(32 * nb, which), W8_SCALE, scr, lane); }
        else { const int kb = q >> 5, nb = q & 31; transpose_item8(I.m_w_down + (size_t)le * ED * D, ED, D, ws + M_DN + (size_t)le * D * ED, kb, nb, 32 * nb, W8_SCALE, scr, lane); }
    }
    constexpr int I_WIN = 16 * 128, I_WOUT = 32 * 32, I_QKV = 16 * 48, I_WO = 16 * 32, I_PW = 4 * 8, I_FG = 16 * 88, I_FD = 44 * 32;
    constexpr int NSM = 2 * I_WIN + 2 * I_WOUT + I_QKV + I_WO + 4 * I_PW + 4 * I_FG + 2 * I_FD;
    for (int it = gw; it < NSM; it += NGW) {
        int r = it;
        if (r < 2 * I_WIN) { const int j = r / I_WIN, q = r % I_WIN; transpose_item(I.a_w_in + (size_t)j * D * 4096, D, 4096, (bf16*)(ws + W_IN) + (size_t)j * 4096 * D, q / 128, q % 128, 32 * (q % 128), scr, lane); continue; } r -= 2 * I_WIN;
        if (r < 2 * I_WOUT) { const int j = r / I_WOUT, q = r % I_WOUT; transpose_item(I.a_w_out + (size_t)j * ADIM * D, ADIM, D, (bf16*)(ws + W_OUT) + (size_t)j * D * ADIM, q / 32, q % 32, 32 * (q % 32), scr, lane); continue; } r -= 2 * I_WOUT;
        if (r < I_QKV) { transpose_item(I.b_w_qkv, D, QKVW, (bf16*)(ws + W_QKV), r / 48, r % 48, qkv_row(32 * (r % 48)), scr, lane); continue; } r -= I_QKV;
        if (r < I_WO) { transpose_item(I.b_w_o, D, D, (bf16*)(ws + W_O), r / 32, r % 32, 32 * (r % 32), scr, lane); continue; } r -= I_WO;
        if (r < 4 * I_PW) { const int j = r / I_PW, q = r % I_PW; transpose_item(I.p_w + (size_t)j * 65536, 256, 256, (bf16*)(ws + W_P) + (size_t)j * 65536, q / 8, q % 8, 32 * (q % 8), scr, lane); continue; } r -= 4 * I_PW;
        if (r < 4 * I_FG) { const int f = r / (2 * I_FG), which = (r / I_FG) & 1, q = r % I_FG; const float* W = (which ? I.f_w_up : I.f_w_gate) + (size_t)f * D * FF;
            transpose_item(W, D, FF, (bf16*)(ws + W_GU) + (size_t)f * 2 * FF * D, q / 88, q % 88, gu_row(32 * (q % 88), which), scr, lane); continue; } r -= 4 * I_FG;
        { const int f = r / I_FD, q = r % I_FD; transpose_item(I.f_w_down + (size_t)f * FF * D, FF, D, (bf16*)(ws + W_DN) + (size_t)f * D * FF, q / 32, q % 32, 32 * (q % 32), scr, lane); }
    }
}
__device__ __forceinline__ void p0_adaln(const float* cvec, const float* cctx, const float* ada_w, unsigned char* ws, int lane, int wave, int G) {
    const int gw = (int)blockIdx.x * NWAVES + wave, NGW = G * NWAVES;
    for (int it = gw; it < 4 * 24 * 8; it += NGW) {
        const int i = it / 192, r = it % 192, cb = r >> 3, kc = r & 7;
        float sv[5][2];
#pragma unroll
        for (int b = 0; b < 5; ++b)
#pragma unroll
            for (int h = 0; h < 2; ++h) { const float xv = (b < 4 ? cvec + b * D : cctx)[kc * 128 + h * 64 + lane]; sv[b][h] = xv * pg8::sigmoidf_(xv); }
        const float* Wp = ada_w + (size_t)i * D * 6144 + (size_t)(kc * 128) * 6144 + cb * 256 + lane * 4;
        f32x4 a[5];
#pragma unroll
        for (int b = 0; b < 5; ++b) a[b] = (f32x4){0.f, 0.f, 0.f, 0.f};
#pragma unroll
        for (int h = 0; h < 2; ++h) {
#pragma unroll 8
            for (int kk = 0; kk < 64; ++kk) { const f32x4 w = *(const f32x4*)(Wp + (size_t)(h * 64 + kk) * 6144);
#pragma unroll
                for (int b = 0; b < 5; ++b) { const float s = __shfl(sv[b][h], kk); a[b] = a[b] + w * s; } }
        }
        const int col = cb * 256 + lane * 4;
#pragma unroll
        for (int b = 0; b < 5; ++b) *(f32x4*)((float*)(ws + WS_MODP) + ((size_t)(kc * 4 + i) * 5 + b) * 6144 + col) = a[b];
    }
    for (int it = gw; it < 16; it += NGW) {
        const int idx = it * 64 + lane, p = idx >> 4, f = idx & 15;
        const float inv = f == 0 ? 1.000000000e+00f : f == 1 ? 5.623413324e-01f : f == 2 ? 3.162277639e-01f : f == 3 ? 1.778279394e-01f : f == 4 ? 1.000000015e-01f : f == 5 ? 5.623413250e-02f
                        : f == 6 ? 3.162277490e-02f : f == 7 ? 1.778279431e-02f : f == 8 ? 9.999999776e-03f : f == 9 ? 5.623413250e-03f : f == 10 ? 3.162277630e-03f : f == 11 ? 1.778279431e-03f
                        : f == 12 ? 1.000000047e-03f : f == 13 ? 5.623413017e-04f : f == 14 ? 3.162277571e-04f : 1.778279402e-04f;
        const float angf = (float)p * inv; const double xd = (double)angf;
        const double kq = __builtin_rint(xd * 0.63661977236758134308); double rr = __builtin_fma(-kq, 1.57079632679489655800e+00, xd); rr = __builtin_fma(-kq, 6.12323399573676603587e-17, rr);
        const double r2 = rr * rr;
        double sp = -7.6471637318198164759e-13; sp = sp * r2 + 1.6059043836821614599e-10; sp = sp * r2 - 2.5052108385441718775e-08; sp = sp * r2 + 2.7557319223985890653e-06; sp = sp * r2 - 1.9841269841269841270e-04;
        sp = sp * r2 + 8.3333333333333333333e-03; sp = sp * r2 - 1.6666666666666666667e-01; const double sn = rr + rr * r2 * sp;
        double cp = 4.7794773323873852974e-14; cp = cp * r2 - 1.1470745597729724714e-11; cp = cp * r2 + 2.0876756987868098979e-09; cp = cp * r2 - 2.7557319223985890653e-07; cp = cp * r2 + 2.4801587301587301587e-05;
        cp = cp * r2 - 1.3888888888888888889e-03; cp = cp * r2 + 4.1666666666666666667e-02; cp = cp * r2 - 0.5; const double cs = 1.0 + r2 * cp;
        const int qd = (int)kq & 3; const double sv_ = qd == 0 ? sn : qd == 1 ? cs : qd == 2 ? -sn : -cs, cv_ = qd == 0 ? cs : qd == 1 ? -sn : qd == 2 ? -cs : sn;
        ((float*)(ws + WS_TAB))[idx] = (float)cv_; ((float*)(ws + WS_TAB + 4096))[idx] = (float)sv_;
    }
}


template <int MODE>
__device__ __forceinline__ void norm_phase(LAS unsigned char* lds, int tid, int lane, int wave, int G, int nrows,
        const float* srcL, const float* srcC, float* xs_out, const float* ng, const float* modsL, int w, bf16* H,
        const bf16* Y, const int* prow, const float* gprev,
        const float* router, unsigned* cnt, int* tok_e, int* tok_s, float* tok_g) {
    const int rpb = (nrows + G - 1) / G, r0 = (int)blockIdx.x * rpb, r1 = (r0 + rpb < nrows) ? r0 + rpb : nrows;
    LAS float* RT = (LAS float*)lds;
    LAS int* LE = (LAS int*)(lds + 32768); LAS float* LG = (LAS float*)(lds + 32768 + 4096); LAS int* LS = (LAS int*)(lds + 32768 + 8192); LAS int* LBASE = (LAS int*)(lds + 32768 + 12288);
    if (MODE == 1) { for (int i = tid; i < 2048; i += NWAVES * 64) ((LAS f32x4*)RT)[i] = ((const f32x4*)router)[i]; __syncthreads(); }
    int cur_b = -1; f32x4 gsv[4], shv[4], gpv[4];
    for (int r = r0 + wave; r < r1; r += NWAVES) {
        const int bidx = r < TL ? (r >> 12) : 4;
        if (bidx != cur_b) { cur_b = bidx;
#pragma unroll
            for (int j = 0; j < 4; ++j) { const int col = 4 * lane + 256 * j; const f32x4 g = *(const f32x4*)(ng + col), sc = *(const f32x4*)(modsL + bidx * 6144 + (3 * w + 1) * 1024 + col);
                gsv[j] = g * (sc + 1.f); shv[j] = *(const f32x4*)(modsL + bidx * 6144 + (3 * w) * 1024 + col);
                if (MODE == 2) gpv[j] = *(const f32x4*)(gprev + bidx * 6144 + col); } }
        const float* xr = (r < TL) ? srcL + (size_t)r * D : srcC + (size_t)(r - TL) * D;
        f32x4 v[4];
#pragma unroll
        for (int j = 0; j < 4; ++j) v[j] = *(const f32x4*)(xr + 4 * lane + 256 * j);
        if (MODE == 2) { const int p1 = prow[2 * r], p2 = prow[2 * r + 1];
#pragma unroll
            for (int j = 0; j < 4; ++j) { const u32x2 a = *(const u32x2*)(Y + (size_t)p1 * D + 4 * lane + 256 * j), b = *(const u32x2*)(Y + (size_t)p2 * D + 4 * lane + 256 * j);
                const f32x4 ys = (f32x4){bf_lo(a.x) + bf_lo(b.x), bf_hi(a.x) + bf_hi(b.x), bf_lo(a.y) + bf_lo(b.y), bf_hi(a.y) + bf_hi(b.y)};
                v[j] = v[j] + gpv[j] * ys; *(f32x4*)(xs_out + (size_t)r * D + 4 * lane + 256 * j) = v[j]; } }
        float ss = 0.f;
#pragma unroll
        for (int j = 0; j < 4; ++j) ss += (v[j].x * v[j].x + v[j].y * v[j].y) + (v[j].z * v[j].z + v[j].w * v[j].w);
        const float rstd = 1.0f / sqrtf(wave_sum(ss) * (1.f / D) + EPS);
        f32x4 hv[4];
#pragma unroll
        for (int j = 0; j < 4; ++j) { hv[j] = v[j] * rstd * gsv[j] + shv[j];
            if (MODE == 1) { *(unsigned*)((unsigned char*)H + (size_t)r * D + 4 * lane + 256 * j) = pg8::pk4_fp8(hv[j].x * A8_SCALE, hv[j].y * A8_SCALE, hv[j].z * A8_SCALE, hv[j].w * A8_SCALE); }
            else { u32x2 o; o.x = cvt_pk_bf16(hv[j].x, hv[j].y); o.y = cvt_pk_bf16(hv[j].z, hv[j].w); *(u32x2*)(H + (size_t)r * D + 4 * lane + 256 * j) = o; } }
        if (MODE == 1) {
            float lg[8];
#pragma unroll
            for (int e = 0; e < 8; ++e) lg[e] = 0.f;
#pragma unroll
            for (int j = 0; j < 4; ++j)
#pragma unroll
                for (int i = 0; i < 4; ++i) { const LAS f32x4* rp = (const LAS f32x4*)(RT + (4 * lane + 256 * j + i) * 8); const f32x4 ra = rp[0], rb = rp[1]; const float hx = hv[j][i];
                    lg[0] += hx * ra.x; lg[1] += hx * ra.y; lg[2] += hx * ra.z; lg[3] += hx * ra.w; lg[4] += hx * rb.x; lg[5] += hx * rb.y; lg[6] += hx * rb.z; lg[7] += hx * rb.w; }
#pragma unroll
            for (int e = 0; e < 8; ++e) lg[e] = wave_sum(lg[e]);
            float b1 = lg[0]; int i1 = 0;
#pragma unroll
            for (int e = 1; e < 8; ++e) if (lg[e] > b1) { b1 = lg[e]; i1 = e; }
            float b2 = -INFINITY; int i2 = 0;
#pragma unroll
            for (int e = 0; e < 8; ++e) if (e != i1 && lg[e] > b2) { b2 = lg[e]; i2 = e; }
            const float ex = __expf(b2 - b1), g1 = 1.f / (1.f + ex), g2 = ex * g1;
            if (lane == 0) { const int li = 2 * (r - r0); LE[li] = i1; LE[li + 1] = i2; LG[li] = g1; LG[li + 1] = g2; }
        }
    }
    if (MODE == 1) {
        __syncthreads();
        const int n2 = 2 * (r1 - r0 > 0 ? r1 - r0 : 0);
        if (tid < 8) { int n = 0; for (int i = 0; i < n2; ++i) if (LE[i] == tid) { LS[i] = n; ++n; }
            LBASE[tid] = (int)__hip_atomic_fetch_add(cnt + tid, (unsigned)n, __ATOMIC_RELAXED, __HIP_MEMORY_SCOPE_AGENT); }
        __syncthreads();
        for (int i = tid; i < n2; i += NWAVES * 64) { const int e = LE[i]; tok_e[2 * r0 + i] = e; tok_s[2 * r0 + i] = LBASE[e] + LS[i]; tok_g[2 * r0 + i] = LG[i]; }
        __syncthreads();
    }
}

struct MoeLayout { int tp[9]; };
__device__ __forceinline__ MoeLayout moe_layout(const unsigned* cnt) {
    MoeLayout L; L.tp[0] = 0;
#pragma unroll
    for (int e = 0; e < 8; ++e) { const unsigned c = __hip_atomic_load(cnt + e, __ATOMIC_RELAXED, __HIP_MEMORY_SCOPE_AGENT); L.tp[e + 1] = L.tp[e] + (int)((c + 255u) >> 8); }
    return L;
}
__device__ __forceinline__ void permute_phase(int lane, int wave, int G, const unsigned* cnt, const int* tok_e, const int* tok_s, const float* tok_g, const bf16* H, bf16* AS, float* gwv, int* prow) {
    const MoeLayout L = moe_layout(cnt);
    const int gw = (int)blockIdx.x * NWAVES + wave, NGW = G * NWAVES;
    for (int t = gw; t < TL; t += NGW) {
        const u32x4 a = *(const u32x4*)((const unsigned char*)H + (size_t)t * D + lane * 16);
#pragma unroll
        for (int j = 0; j < 2; ++j) { const int e = tok_e[2 * t + j], s = tok_s[2 * t + j]; int base = 0;
#pragma unroll
            for (int k = 1; k < 8; ++k) base = (e == k) ? L.tp[k] : base;
            const int row = base * 256 + s;
            *(u32x4*)((unsigned char*)AS + (size_t)row * D + lane * 16) = a;
            if (lane == 0) { gwv[row] = tok_g[2 * t + j]; prow[2 * t + j] = row; } }
    }
}
__device__ __forceinline__ void final_phase(int lane, int wave, int G, const float* XS, const bf16* Y, const int* prow, const float* gprev, float* out) {
    const int gw = (int)blockIdx.x * NWAVES + wave, NGW = G * NWAVES;
    for (int r = gw; r < TL; r += NGW) { const int bidx = r >> 12; const int p1 = prow[2 * r], p2 = prow[2 * r + 1];
#pragma unroll
        for (int j = 0; j < 4; ++j) { const int col = 4 * lane + 256 * j; const u32x2 a = *(const u32x2*)(Y + (size_t)p1 * D + col), b = *(const u32x2*)(Y + (size_t)p2 * D + col);
            const f32x4 ys = (f32x4){bf_lo(a.x) + bf_lo(b.x), bf_hi(a.x) + bf_hi(b.x), bf_lo(a.y) + bf_lo(b.y), bf_hi(a.y) + bf_hi(b.y)};
            *(f32x4*)(out + (size_t)r * D + col) = *(const f32x4*)(XS + (size_t)r * D + col) + *(const f32x4*)(gprev + bidx * 6144 + col) * ys; } }
}
__device__ __forceinline__ void copy_phase(int lane, int wave, int G, const float* XS, float* out) {
    const int gw = (int)blockIdx.x * NWAVES + wave, NGW = G * NWAVES;
    for (int r = gw; r < TL; r += NGW)
#pragma unroll
        for (int j = 0; j < 4; ++j) { const int col = 4 * lane + 256 * j; *(f32x4*)(out + (size_t)r * D + col) = *(const f32x4*)(XS + (size_t)r * D + col); }
}

typedef short v4i16_t __attribute__((ext_vector_type(4)));
__device__ __forceinline__ void sgu_phase(LAS unsigned char* lds, int tid, int nchunks, const bf16* Z, const float* rowss, const float* wsp, const float* bsp, const float* vg, bf16* GT) {
    const int lane = tid & 63, wave = __builtin_amdgcn_readfirstlane(tid >> 6), fr = lane & 15, fq = lane >> 4;
    LAS float* RS = (LAS float*)lds; LAS unsigned char* WL = lds + 1024; LAS unsigned char* VL = lds + 1024 + 128 * 272;
    const int nunits = nchunks * 8;
    for (int un = (int)blockIdx.x; un < nunits; un += (int)gridDim.x) {
        const int ch = un >> 3, g = un & 7, rbase = ch * 128;
        if (tid < 128) { const f32x4* rp = (const f32x4*)(rowss + (size_t)(rbase + tid) * 32); float ssum = 0.f;
#pragma unroll
            for (int q = 0; q < 8; ++q) { const f32x4 pv = rp[q]; ssum += (pv.x + pv.y) + (pv.z + pv.w); }
            RS[tid] = 1.0f / sqrtf(ssum * (1.f / ADIM) + EPS); }
        __syncthreads();
#pragma unroll
        for (int k = 0; k < 8; ++k) { const int idx = tid + 512 * k, t = idx >> 5, s = (idx & 31) * 4;
            const f32x4 wv = *(const f32x4*)(wsp + (size_t)g * 16384 + t * 128 + s) * *(const LAS f32x4*)(RS + s);
            u32x2 o; o.x = cvt_pk_bf16(wv.x, wv.y); o.y = cvt_pk_bf16(wv.z, wv.w); *(LAS u32x2*)(WL + t * 272 + s * 2) = o; }
#pragma unroll
        for (int k = 0; k < 8; ++k) { const int idx = tid + 512 * k, sr = idx >> 5, c = idx & 31;
            *(LAS u32x4*)(VL + sr * 528 + c * 16) = *(const u32x4*)(Z + (size_t)(rbase + sr) * 4096 + ADIM + g * 256 + c * 8); }
        __syncthreads();
        f32x4 acc[2][8];
#pragma unroll
        for (int mb = 0; mb < 2; ++mb)
#pragma unroll
            for (int nb = 0; nb < 8; ++nb) acc[mb][nb] = (f32x4){0.f, 0.f, 0.f, 0.f};
#pragma unroll
        for (int ks = 0; ks < 4; ++ks) {
            bf16x8 a[2];
#pragma unroll
            for (int mb = 0; mb < 2; ++mb) { LAS unsigned char* p = VL + (32 * ks + 8 * fq + (fr >> 2)) * 528 + (32 * wave + 16 * mb + 4 * (fr & 3)) * 2;
                const v4i16_t lo = __builtin_amdgcn_ds_read_tr16_b64_v4i16((LAS v4i16_t*)p), hi = __builtin_amdgcn_ds_read_tr16_b64_v4i16((LAS v4i16_t*)(p + 4 * 528));
                a[mb] = (bf16x8){lo[0], lo[1], lo[2], lo[3], hi[0], hi[1], hi[2], hi[3]}; }
#pragma unroll
            for (int nb = 0; nb < 8; ++nb) { const bf16x8 b = *(const LAS bf16x8*)(WL + (16 * nb + fr) * 272 + (32 * ks + 8 * fq) * 2);
#pragma unroll
                for (int mb = 0; mb < 2; ++mb) acc[mb][nb] = __builtin_amdgcn_mfma_f32_16x16x32_bf16(a[mb], b, acc[mb][nb], 0, 0, 0); }
        }
#pragma unroll
        for (int mb = 0; mb < 2; ++mb) { const int dcol = g * 256 + 32 * wave + 16 * mb + 4 * fq; const f32x4 vgv = *(const f32x4*)(vg + dcol);
#pragma unroll
            for (int nb = 0; nb < 8; ++nb) { const int t = 16 * nb + fr; const size_t row = (size_t)(rbase + t); const float bsv = bsp[g * 128 + t];
                const u32x2 uu = *(const u32x2*)(Z + row * 4096 + dcol); const f32x4 mx = acc[mb][nb] * vgv + bsv;
                u32x2 o; o.x = cvt_pk_bf16(bf_lo(uu.x) * mx.x, bf_hi(uu.x) * mx.y); o.y = cvt_pk_bf16(bf_lo(uu.y) * mx.z, bf_hi(uu.y) * mx.w);
                *(u32x2*)(GT + row * ADIM + dcol) = o; } }
        __syncthreads();
    }
}

__device__ __forceinline__ void pool_phase(int tid, int G, const bf16* H, bf16* PB) {
    const int chunk = tid & 127, rs = tid >> 7, c0 = chunk * 8, half = 1 << (c0 >> 8);
    for (int un = (int)blockIdx.x; un < TL / 32; un += G) {
        for (int rr = 0; rr < 8; ++rr) { const int row = un * 32 + rs * 8 + rr, tb = row & (SEQ - 1), bb = row - tb;
            const int lo = tb - half > 0 ? tb - half : 0, hi = tb + half - 1 < SEQ - 1 ? tb + half - 1 : SEQ - 1;
            float s[8];
#pragma unroll
            for (int i = 0; i < 8; ++i) s[i] = 0.f;
            for (int q = lo; q <= hi; ++q) { const u32x4 v = *(const u32x4*)(H + (size_t)(bb + q) * D + c0);
                s[0] += bf_lo(v.x); s[1] += bf_hi(v.x); s[2] += bf_lo(v.y); s[3] += bf_hi(v.y); s[4] += bf_lo(v.z); s[5] += bf_hi(v.z); s[6] += bf_lo(v.w); s[7] += bf_hi(v.w); }
            const u32x4 o = *(const u32x4*)(H + (size_t)row * D + c0); const float inv = 1.f / (float)(hi - lo + 1);
            u32x4 w; w.x = cvt_pk_bf16(s[0] * inv - bf_lo(o.x), s[1] * inv - bf_hi(o.x)); w.y = cvt_pk_bf16(s[2] * inv - bf_lo(o.y), s[3] * inv - bf_hi(o.y));
            w.z = cvt_pk_bf16(s[4] * inv - bf_lo(o.z), s[5] * inv - bf_hi(o.z)); w.w = cvt_pk_bf16(s[6] * inv - bf_lo(o.w), s[7] * inv - bf_hi(o.w));
            *(u32x4*)(PB + (size_t)row * D + c0) = w; }
    }
}

struct Args { const float* in[25]; float* out; unsigned char* ws; int ph_lo, ph_hi; };
#define CAS __attribute__((address_space(4)))
__device__ __forceinline__ const CAS char* karg_base() { const CAS char* p = (const CAS char*)__builtin_amdgcn_kernarg_segment_ptr(); asm volatile("" : "+s"(p)); return p; }
__device__ __forceinline__ const float* karg_in(int k) { return *(const float* const CAS*)(karg_base() + 8 * k); }
__device__ __forceinline__ float* karg_out() { return *(float* const CAS*)(karg_base() + 200); }
__device__ __forceinline__ unsigned char* karg_ws() { return *(unsigned char* const CAS*)(karg_base() + 208); }
#define WSB(T, off) ((T*)(karg_ws() + (off)))
#define MODS(layer, which) (WSB(float, WS_MODS) + (layer) * 5 * 6144 + (which) * 1024)
#define XS_ WSB(float, WS_XS)
#define H_ WSB(bf16, WS_H)
#define CNT(l) ((unsigned*)(WSB(unsigned, WS_CTL) + CW_CNT + 64 * (l)))
#define NORM_G(i, w) (karg_in(6) + ((i) * 2 + (w)) * 1024)
__global__ void __launch_bounds__(NWAVES * 64, 2) trunk_fwd(Args args) {
    extern __shared__ __attribute__((aligned(16))) unsigned char lds_raw[];
    LAS unsigned char* const lds = (LAS unsigned char*)lds_raw;
    volatile LAS unsigned* const MISC = (volatile LAS unsigned*)(lds + MISC_OFF);
    const int wave = __builtin_amdgcn_readfirstlane((int)threadIdx.x >> 6), G = gridDim.x, bx = blockIdx.x;
#define lane ((int)__builtin_amdgcn_mbcnt_hi(~0u, __builtin_amdgcn_mbcnt_lo(~0u, 0u)))
#define tid (wave * 64 + lane)
    const int vcu = (G % 8 == 0) ? (bx % 8) * (G / 8) + bx / 8 : bx;
    static_assert(offsetof(Args, out) == 200 && offsetof(Args, ws) == 208, "kernarg layout");

    for (int u = (int)threadIdx.x; u < (LDS_BYTES - LDSCTL_OFF) / 4; u += NWAVES * 64) ((LAS unsigned*)(lds + LDSCTL_OFF))[u] = 0u;
    __syncthreads();
    XcdBarrier bar; bar.bar = WSB(unsigned, WS_CTL) + CW_BAR; bar.x = 0; bar.st = nullptr;
    if (!MK_PER_PHASE) bar = xcd_barrier_post(WSB(unsigned, WS_CTL) + CW_BAR, MISC + 8, tid);
#define GRID_BAR() do { if (MK_PER_PHASE) { if (tid == 0) __hip_atomic_store((gu32*)WSB(unsigned, WS_CTL) + CW_TMO, 0xBADBA0u, RLX_AGENT); } else { xcd_barrier(bar, tid); } } while (0)
    const int lo = args.ph_lo, hi = args.ph_hi;
#define IN(k) (lo <= (k) && (k) < hi && (k) <= DBG_STOP)
#define SEAM(k) do { if (IN(k) && IN((k) + 1)) GRID_BAR(); } while (0)
#define PHASE(k, ...) if (IN(k)) { { __VA_ARGS__ } if (DUP_PHASE == (k)) { GRID_BAR(); { __VA_ARGS__ } } } SEAM(k);
#define PHASE_LAST(k, ...) if (IN(k)) { __VA_ARGS__ }
#define GEMM_PHASE(EPI, ORD, nM, nN, gm, ep) do { pg8::ORD S_; S_.init((nM), (nN), G, bx); pg8::gemm_phase<pg8::EPI, pg8::ORD, true>(lds + RING_OFF, tid, gm, S_, ep); } while (0)
#define MOE_PHASE(EPI, l, nN, gm, ep) do { const MoeLayout L_ = moe_layout(CNT(l)); pg8::MoeOrder S_; S_.init(L_.tp[8], (nN), G, bx); _Pragma("unroll") for (int k_ = 0; k_ < 8; ++k_) S_.tp[k_] = L_.tp[k_]; \
        pg8::gemm_phase<pg8::EPI, pg8::MoeOrder, true, true>(lds + RING_OFF, tid, gm, S_, ep); } while (0)
#define NORM0(nrows, srcL, srcC, layer, w) norm_phase<0>(lds, tid, lane, wave, G, nrows, srcL, srcC, nullptr, NORM_G(layer, w), MODS(layer, 0), w, H_, nullptr, nullptr, nullptr, nullptr, nullptr, nullptr, nullptr, nullptr)

    PHASE(0, p0_adaln(karg_in(1), karg_in(3), karg_in(4), karg_ws(), lane, wave, G);)
    PHASE(1, In I; I.x = karg_in(0); I.c = karg_in(1); I.ctx = karg_in(2); I.c_ctx = karg_in(3); I.ada_w = karg_in(4); I.ada_b = karg_in(5); I.norm_g = karg_in(6); I.a_w_in = karg_in(7); I.a_v_g = karg_in(8);
        I.a_ws = karg_in(9); I.a_bs = karg_in(10); I.a_w_out = karg_in(11); I.b_w_qkv = karg_in(12); I.b_q_g = karg_in(13); I.b_k_g = karg_in(14); I.b_w_o = karg_in(15); I.p_w = karg_in(16); I.p_scale = karg_in(17);
        I.f_w_gate = karg_in(18); I.f_w_up = karg_in(19); I.f_w_down = karg_in(20); I.m_router = karg_in(21); I.m_w_gate = karg_in(22); I.m_w_up = karg_in(23); I.m_w_down = karg_in(24);
        p1_convert(I, karg_ws(), lds, lane, wave, G);)
    PHASE(2, NORM0(TT, karg_in(0), karg_in(2), 0, 0);)
    PHASE(3, pg8::Gemm g{H_, WSB(const bf16, W_IN), D, D, 0, 0}; pg8::EpiGelu E{WSB(bf16, WS_BIG), WSB(float, WS_RSP)}; GEMM_PHASE(EpiGelu, StaticOrder, TT / 256, 16, g, E);)
    PHASE(4, sgu_phase(lds, tid, TT / 128, WSB(const bf16, WS_BIG), WSB(const float, WS_RSP), karg_in(9), karg_in(10), karg_in(8), WSB(bf16, WS_R2));)
    PHASE(5, pg8::Gemm g{WSB(const bf16, WS_R2), WSB(const bf16, W_OUT), ADIM, ADIM, 0, 0}; pg8::EpiResid E{karg_in(0), karg_in(2), XS_, MODS(0, 2), nullptr}; GEMM_PHASE(EpiResid, StaticOrder, TT / 256, 4, g, E);)
    PHASE(6, NORM0(TT, XS_, XS_ + (size_t)TL * D, 0, 1);)
    PHASE(7, pg8::Gemm g{H_, WSB(const bf16, W_GU), D, D, 0, 0}; pg8::EpiSwiGLU E{WSB(bf16, WS_BIG), FF}; GEMM_PHASE(EpiSwiGLU, StaticOrder, TT / 256, 2 * FF / 256, g, E);)
    PHASE(8, pg8::Gemm g{WSB(const bf16, WS_BIG), WSB(const bf16, W_DN), FF, FF, 0, 0}; float* xs = XS_; pg8::EpiResid E{xs, xs + (size_t)TL * D, xs, MODS(0, 5), nullptr}; GEMM_PHASE(EpiResid, StaticOrder, TT / 256, 4, g, E);)
    PHASE(9, NORM0(TT, XS_, XS_ + (size_t)TL * D, 1, 0);)
    PHASE(10, pg8::Gemm g{H_, WSB(const bf16, W_QKV), D, D, 0, 0};
        pg8::EpiQKV E{WSB(bf16, WS_BIG), WSB(bf16, WS_BIG + 64 * MiB), WSB(bf16, WS_BIG + 73 * MiB), karg_in(13), karg_in(14), WSB(const float, WS_TAB), WSB(const float, WS_TAB + 4096), attn_body::C2};
        GEMM_PHASE(EpiQKV, StaticOrder, TT / 256, QKVW / 256, g, E);)
    PHASE(11, const attn_body::AttnTensors AT{WSB(const attn_body::bf16, WS_BIG), WSB(const attn_body::bf16, WS_BIG + 64 * MiB), WSB(const attn_body::bf16, WS_BIG + 73 * MiB), WSB(attn_body::bf16, WS_BIG + 32 * MiB)};
        const attn_body::StaticOrder S(G, vcu); attn_body::attn_phase<attn_body::StaticOrder>(tid, (char*)lds_raw + RING_OFF, AT, S);)
    PHASE(12, pg8::Gemm g{WSB(const bf16, WS_BIG + 32 * MiB), WSB(const bf16, W_O), D, D, 0, 0}; float* xs = XS_; pg8::EpiResid E{xs, xs + (size_t)TL * D, xs, MODS(1, 2), nullptr}; GEMM_PHASE(EpiResid, StaticOrder, TL / 256, 4, g, E);)
    PHASE(13, norm_phase<1>(lds, tid, lane, wave, G, TL, XS_, XS_ + (size_t)TL * D, nullptr, NORM_G(1, 1), MODS(1, 0), 1, H_, nullptr, nullptr, nullptr, karg_in(21), CNT(0), WSB(int, WS_TOKE), WSB(int, WS_TOKS), WSB(float, WS_TOKG));)
    PHASE(14, permute_phase(lane, wave, G, CNT(0), WSB(const int, WS_TOKE), WSB(const int, WS_TOKS), WSB(const float, WS_TOKG), H_, WSB(bf16, WS_R2), WSB(float, WS_GW), WSB(int, WS_PROW));)
    PHASE(15, pg8::Gemm g{WSB(const bf16, WS_R2), WSB(const bf16, M_GU), D / 2, D / 2, 0, (size_t)ED * D}; pg8::EpiSwiGLU8 E{WSB(unsigned char, WS_BIG), ED, 1.f / (A8_SCALE * W8_SCALE), H8_SCALE}; MOE_PHASE(EpiSwiGLU8, 0, 2 * ED / 256, g, E);)
    PHASE(16, pg8::Gemm g{WSB(const bf16, WS_BIG), WSB(const bf16, M_DN), ED / 2, ED / 2, 0, (size_t)D * ED / 2}; pg8::EpiMoeDown E{WSB(bf16, WS_R2), WSB(const float, WS_GW), 1.f / (H8_SCALE * W8_SCALE)}; MOE_PHASE(EpiMoeDown, 0, 4, g, E);)
    PHASE(17, float* xs = XS_; norm_phase<2>(lds, tid, lane, wave, G, TL, xs, xs + (size_t)TL * D, xs, NORM_G(2, 0), MODS(2, 0), 0, H_, WSB(const bf16, WS_R2), WSB(const int, WS_PROW), MODS(1, 5), nullptr, nullptr, nullptr, nullptr, nullptr);)
    PHASE(18, pool_phase(tid, G, H_, WSB(bf16, WS_BIG));)
    PHASE(19, pg8::Gemm g{WSB(const bf16, WS_BIG), WSB(const bf16, W_P), 256, D, 256, 0}; float* xs = XS_; pg8::EpiResid E{xs, xs + (size_t)TL * D, xs, MODS(2, 2), karg_in(17)}; GEMM_PHASE(EpiResid, StaticOrder, TL / 256, 4, g, E);)
    PHASE(20, NORM0(TL, XS_, XS_ + (size_t)TL * D, 2, 1);)
    PHASE(21, pg8::Gemm g{H_, WSB(const bf16, W_GU) + (size_t)2 * FF * D, D, D, 0, 0}; pg8::EpiSwiGLU E{WSB(bf16, WS_BIG), FF}; GEMM_PHASE(EpiSwiGLU, StaticOrder, TL / 256, 2 * FF / 256, g, E);)
    PHASE(22, pg8::Gemm g{WSB(const bf16, WS_BIG), WSB(const bf16, W_DN) + (size_t)D * FF, FF, FF, 0, 0}; float* xs = XS_; pg8::EpiResid E{xs, xs + (size_t)TL * D, xs, MODS(2, 5), nullptr}; GEMM_PHASE(EpiResid, StaticOrder, TL / 256, 4, g, E);)
    PHASE(23, NORM0(TL, XS_, XS_ + (size_t)TL * D, 3, 0);)
    PHASE(24, pg8::Gemm g{H_, WSB(const bf16, W_IN) + (size_t)4096 * D, D, D, 0, 0}; pg8::EpiGelu E{WSB(bf16, WS_BIG), WSB(float, WS_RSP)}; GEMM_PHASE(EpiGelu, StaticOrder, TL / 256, 16, g, E);)
    PHASE(25, sgu_phase(lds, tid, TL / 128, WSB(const bf16, WS_BIG), WSB(const float, WS_RSP), karg_in(9) + 8 * 16384, karg_in(10) + 8 * 128, karg_in(8) + ADIM, WSB(bf16, WS_R2));)
    PHASE(26, pg8::Gemm g{WSB(const bf16, WS_R2), WSB(const bf16, W_OUT) + (size_t)D * ADIM, ADIM, ADIM, 0, 0}; float* xs = XS_; pg8::EpiResid E{xs, xs + (size_t)TL * D, xs, MODS(3, 2), nullptr}; GEMM_PHASE(EpiResid, StaticOrder, TL / 256, 4, g, E);)
    PHASE(27, norm_phase<1>(lds, tid, lane, wave, G, TL, XS_, XS_ + (size_t)TL * D, nullptr, NORM_G(3, 1), MODS(3, 0), 1, H_, nullptr, nullptr, nullptr, karg_in(21) + 8192, CNT(1), WSB(int, WS_TOKE), WSB(int, WS_TOKS), WSB(float, WS_TOKG));)
    PHASE(28, permute_phase(lane, wave, G, CNT(1), WSB(const int, WS_TOKE), WSB(const int, WS_TOKS), WSB(const float, WS_TOKG), H_, WSB(bf16, WS_R2), WSB(float, WS_GW), WSB(int, WS_PROW));)
    PHASE(29, pg8::Gemm g{WSB(const bf16, WS_R2), WSB(const bf16, M_GU) + (size_t)8 * ED * D, D / 2, D / 2, 0, (size_t)ED * D}; pg8::EpiSwiGLU8 E{WSB(unsigned char, WS_BIG), ED, 1.f / (A8_SCALE * W8_SCALE), H8_SCALE}; MOE_PHASE(EpiSwiGLU8, 1, 2 * ED / 256, g, E);)
    PHASE(30, pg8::Gemm g{WSB(const bf16, WS_BIG), WSB(const bf16, M_DN) + (size_t)8 * D * ED / 2, ED / 2, ED / 2, 0, (size_t)D * ED / 2}; pg8::EpiMoeDown E{WSB(bf16, WS_R2), WSB(const float, WS_GW), 1.f / (H8_SCALE * W8_SCALE)}; MOE_PHASE(EpiMoeDown, 1, 4, g, E);)
    PHASE_LAST(31, final_phase(lane, wave, G, XS_, WSB(const bf16, WS_R2), WSB(const int, WS_PROW), MODS(3, 5), karg_out());)
    if (DBG_STOP < 31 && (MK_PER_PHASE ? (lo == DBG_STOP + 1) : true)) {
        if (!MK_PER_PHASE) GRID_BAR();
        copy_phase(lane, wave, G, XS_, karg_out());
    }
#undef IN
#undef SEAM
#undef lane
#undef tid
}

extern "C" void kernel_launch(void* const* d_in, const int* in_sizes, int n_in, void* d_out, int out_size, void* d_ws, size_t ws_size, hipStream_t stream) {
    static int grid = 0;
    if (grid == 0) {
        if (n_in != 25 || out_size != TL * D || ws_size < WS_END) { fprintf(stderr, "kernel_launch: unexpected problem: n_in %d out %d ws %zu (need %zu)\n", n_in, out_size, ws_size, (size_t)WS_END); grid = -1; return; }
        int dev = 0, cus = 0, per_cu = 0;
        if (hipGetDevice(&dev) != hipSuccess || hipDeviceGetAttribute(&cus, hipDeviceAttributeMultiprocessorCount, dev) != hipSuccess) { grid = -1; return; }
        if (hipFuncSetAttribute((const void*)trunk_fwd, hipFuncAttributeMaxDynamicSharedMemorySize, LDS_BYTES) != hipSuccess) { fprintf(stderr, "kernel_launch: hipFuncSetAttribute failed\n"); grid = -1; return; }
        if (hipOccupancyMaxActiveBlocksPerMultiprocessor(&per_cu, (const void*)trunk_fwd, NWAVES * 64, LDS_BYTES) != hipSuccess || per_cu < 1) fprintf(stderr, "kernel_launch: occupancy query reports %d\n", per_cu);
        (void)hipGetLastError();
        grid = cus;
    }
    if (grid < 0) return;
    if (hipMemsetAsync((char*)d_ws + WS_CTL, 0, CTL_ZERO_BYTES, stream) != hipSuccess) return;
    Args a{};
    for (int i = 0; i < 25; ++i) a.in[i] = (const float*)d_in[i];
    a.out = (float*)d_out; a.ws = (unsigned char*)d_ws;
    if (MK_PER_PHASE) {
        for (int k = 0; k < NPH; ++k) { if (k > DBG_STOP + 1) break; a.ph_lo = k; a.ph_hi = k + 1; hipLaunchKernelGGL(trunk_fwd, dim3(grid), dim3(NWAVES * 64), LDS_BYTES, stream, a); }
    } else { a.ph_lo = 0; a.ph_hi = NPH; hipLaunchKernelGGL(trunk_fwd, dim3(grid), dim3(NWAVES * 64), LDS_BYTES, stream, a); }
}
```
